# Optimizing an MI355X kernel written in HIP

```python
import math
import jax, jax.numpy as jnp
from jax import lax
import numpy as np

D_MODEL = 1024
BATCH = 16
SEQ = 2048
DEPTH = 1

HEAD_DIM = 64
D_MIX = D_MODEL
A_GROUPS = 4
A_WIDTH = A_GROUPS * HEAD_DIM
B_HEADS = 12
B_WIDTH = B_HEADS * HEAD_DIM
CHUNK = 128
DILATED_CONFIGS = ((128, 1), (512, 4), (2048, 16))
NUM_BUCKETS = 32
MAX_DISTANCE = 2048
D_FF = 2816
CONV_WIDTH = 3
IN_COLS = 2 * A_WIDTH + 3 * B_WIDTH
NORM_EPS = 1e-6
NEG_INF = -1e30

kernel_name = "hybrid_gmlp_dilated_attn_convffn"


def rms_norm(x, g):
    xf = x.astype(jnp.float32)
    y = xf * lax.rsqrt(jnp.mean(xf * xf, axis=-1, keepdims=True) + NORM_EPS)
    return (y * g.astype(jnp.float32)).astype(x.dtype)


def t5_bucket(dist):
    max_exact = NUM_BUCKETS // 2
    d = jnp.maximum(dist, 1).astype(jnp.float32)
    large = max_exact + (jnp.log(d / max_exact) / math.log(MAX_DISTANCE / max_exact)
                         * (NUM_BUCKETS - max_exact))
    large = jnp.minimum(large.astype(jnp.int32), NUM_BUCKETS - 1)
    return jnp.where(dist < max_exact, dist, large)


def spatial_gating(u, v, ln_g, ln_b, w_s, b_s):
    B, T, G, hd = u.shape
    u = jax.nn.gelu(u)
    vf = jax.nn.gelu(v).astype(jnp.float32)
    mu = jnp.mean(vf, axis=-1, keepdims=True)
    var = jnp.mean(jnp.square(vf - mu), axis=-1, keepdims=True)
    vn = (vf - mu) * lax.rsqrt(var + NORM_EPS) * ln_g.astype(jnp.float32) + ln_b.astype(jnp.float32)
    vc = vn.reshape(B, T // CHUNK, CHUNK, G, hd)
    tril = jnp.tril(jnp.ones((CHUNK, CHUNK), jnp.float32))
    w = w_s.astype(jnp.float32) * tril[None]
    z = jnp.einsum('gts,bcsgd->bctgd', w, vc) + b_s.astype(jnp.float32).T[None, None, :, :, None]
    return u * z.reshape(B, T, G, hd).astype(u.dtype)


def dilated_segment(q, k, v, rel_bias, window, dil):
    B, T, H, D = q.shape
    nw = window // dil
    seg = nw * dil
    nb = -(-T // seg)
    Tp = nb * seg

    def blocks(a):
        a = jnp.pad(a, ((0, 0), (0, Tp - T), (0, 0), (0, 0)))
        return a.reshape(B, nb, nw, dil, H, D)

    def with_prev(a):
        prev = jnp.pad(a, ((0, 0), (1, 0), (0, 0), (0, 0), (0, 0), (0, 0)))[:, :-1]
        return jnp.concatenate([prev, a], axis=2)

    qb = blocks(q)
    kc = with_prev(blocks(k))
    vc = with_prev(blocks(v))

    i = jnp.arange(nw)[:, None]
    j = jnp.arange(2 * nw)[None, :]
    rel = nw + i - j
    band = (rel >= 0) & (rel <= nw)
    key_ok = (jnp.arange(nb)[:, None] * nw + jnp.arange(2 * nw)[None, :] - nw) >= 0
    mask = band[None] & key_ok[:, None, :]
    bias = rel_bias.astype(jnp.float32)[t5_bucket(jnp.maximum(rel, 0) * dil)]
    bias = bias.transpose(2, 0, 1)

    scale = 1.0 / math.sqrt(D)
    logits = jnp.einsum('bnirhd,bnjrhd->bnrhij', qb, kc) * scale + bias[None, None, None]
    logits = jnp.where(mask[None, :, None, None], logits, NEG_INF)
    lse = jax.nn.logsumexp(logits, axis=-1)
    p = jnp.exp(logits - lse[..., None])
    o = jnp.einsum('bnrhij,bnjrhd->bnirhd', p, vc)
    o = o.reshape(B, Tp, H, D)[:, :T]
    lse = lse.transpose(0, 1, 4, 2, 3).reshape(B, Tp, H)[:, :T]
    return o, lse


def dilated_attention(q, k, v, rel_bias):
    outs, lses = [], []
    for window, dil in DILATED_CONFIGS:
        o, lse = dilated_segment(q, k, v, rel_bias, window, dil)
        outs.append(o)
        lses.append(lse)
    o = jnp.stack(outs, axis=0)
    w = jax.nn.softmax(jnp.stack(lses, axis=0), axis=0)
    return jnp.sum(w[..., None] * o, axis=0)


def causal_dwconv(h, w, b):
    T = h.shape[1]
    hp = jnp.pad(h, ((0, 0), (CONV_WIDTH - 1, 0), (0, 0)))
    out = b
    for kk in range(CONV_WIDTH):
        out = out + hp[:, kk:kk + T] * w[kk]
    return out


def setup_inputs(seed: int = 0) -> dict:
    key = jax.random.key(seed)
    ks = jax.random.split(key, 20)
    f32 = jnp.float32

    def nrm(k, shape, s):
        return jax.random.normal(k, shape, f32) * s

    L = DEPTH
    return {
        "x": jax.random.normal(ks[0], (BATCH, SEQ, D_MODEL), f32),
        "norm_mix_pre": 1.0 + nrm(ks[1], (L, D_MODEL), 0.01),
        "norm_mix_post": 1.0 + nrm(ks[2], (L, D_MODEL), 0.01),
        "norm_ffn_pre": 1.0 + nrm(ks[3], (L, D_MODEL), 0.01),
        "norm_ffn_post": 1.0 + nrm(ks[4], (L, D_MODEL), 0.01),
        "w_in": nrm(ks[5], (L, D_MODEL, IN_COLS), D_MODEL ** -0.5),
        "ln_v_gain": 1.0 + nrm(ks[6], (L, A_GROUPS, HEAD_DIM), 0.01),
        "ln_v_bias": nrm(ks[7], (L, A_GROUPS, HEAD_DIM), 0.01),
        "spatial_w": nrm(ks[8], (L, A_GROUPS, CHUNK, CHUNK), CHUNK ** -0.5),
        "spatial_b": 1.0 + nrm(ks[9], (L, A_GROUPS, CHUNK), 0.01),
        "rel_bias": nrm(ks[10], (NUM_BUCKETS, B_HEADS), 0.5),
        "w_out": nrm(ks[11], (L, D_MIX, D_MODEL), D_MIX ** -0.5),
        "w_gate": nrm(ks[12], (L, D_MODEL, D_FF), D_MODEL ** -0.5),
        "w_up": nrm(ks[13], (L, D_MODEL, D_FF), D_MODEL ** -0.5),
        "conv_w": nrm(ks[14], (L, CONV_WIDTH, D_FF), CONV_WIDTH ** -0.5),
        "conv_b": nrm(ks[15], (L, D_FF), 0.01),
        "w_down": nrm(ks[16], (L, D_FF, D_MODEL), D_FF ** -0.5),
    }


def reference(x, norm_mix_pre, norm_mix_post, norm_ffn_pre, norm_ffn_post, w_in,
              ln_v_gain, ln_v_bias, spatial_w, spatial_b, rel_bias, w_out,
              w_gate, w_up, conv_w, conv_b, w_down):
    B, T, _ = x.shape
    for l in range(DEPTH):
        h = rms_norm(x, norm_mix_pre[l])
        proj = h @ w_in[l]
        o0 = 0
        ua = proj[..., o0:o0 + A_WIDTH].reshape(B, T, A_GROUPS, HEAD_DIM); o0 += A_WIDTH
        va = proj[..., o0:o0 + A_WIDTH].reshape(B, T, A_GROUPS, HEAD_DIM); o0 += A_WIDTH
        qb = proj[..., o0:o0 + B_WIDTH].reshape(B, T, B_HEADS, HEAD_DIM); o0 += B_WIDTH
        kb = proj[..., o0:o0 + B_WIDTH].reshape(B, T, B_HEADS, HEAD_DIM); o0 += B_WIDTH
        vb = proj[..., o0:o0 + B_WIDTH].reshape(B, T, B_HEADS, HEAD_DIM)

        a_out = spatial_gating(ua, va, ln_v_gain[l], ln_v_bias[l], spatial_w[l], spatial_b[l])
        b_out = dilated_attention(qb.astype(jnp.float32), kb.astype(jnp.float32),
                                  vb.astype(jnp.float32), rel_bias)
        mix = jnp.concatenate([a_out.reshape(B, T, A_WIDTH),
                               b_out.reshape(B, T, B_WIDTH).astype(x.dtype)], axis=-1)
        x = x + rms_norm(mix @ w_out[l], norm_mix_post[l])

        h = rms_norm(x, norm_ffn_pre[l])
        g = jax.nn.gelu(causal_dwconv(h @ w_gate[l], conv_w[l], conv_b[l]))
        y = (g * (h @ w_up[l])) @ w_down[l]
        x = x + rms_norm(y, norm_ffn_post[l])
    return x
```

```cpp
#include <hip/hip_runtime.h>
#include <cstdio>
#include <cstdint>
#include <cmath>
namespace pg8 {
#define PG8_LAS __attribute__((address_space(3)))
typedef unsigned short bf16_t;
typedef short bf16x8 __attribute__((ext_vector_type(8)));
typedef float f32x4 __attribute__((ext_vector_type(4)));
typedef unsigned u32x4 __attribute__((ext_vector_type(4)));
constexpr int BM = 256, BK = 64, HALF = 128, HTB = HALF * BK * 2  , STAGE_BYTES = 8 * HTB, NXCD = 8, WGM = 8;

__host__ __device__ __forceinline__ int lds_byte(int r, int c) { const int st = (r >> 4) * 2 + (c >> 5), rr = r & 15, cc = c & 31, ob = rr * 64 + cc * 2; return st * 1024 + (ob ^ (((ob >> 9) & 1) << 5)); }
__host__ __device__ __forceinline__ void stage_rc(int b, int& R, int& C) { const int st = b / 1024, sb = b % 1024, swz = sb ^ (((sb >> 9) & 1) << 5); R = (st >> 1) * 16 + swz / 64; C = (st & 1) * 32 + (swz % 64) / 2; }
__host__ __device__ __forceinline__ int perm32(int rho) { const int n = rho >> 4, i = rho & 15; return 8 * (i >> 2) + 4 * n + (i & 3); }

struct Unit { int pm, pn; };
struct Gemm { const bf16_t* A; const bf16_t* Bt; int M, N, K; };

struct StaticOrder {
    int nM, nN, nwg, G, c;
    __host__ __device__ void init(int M, int N, int G_, int c_) { nM = M / BM; nN = N / BM; nwg = nM * nN; G = G_; c = c_; }
    __host__ __device__ bool next(int i, Unit& u) const {
        const long L = (long)i * G + c; if (L >= nwg) return false;
        int wgid = (int)L; { const int q = nwg / NXCD, r = nwg % NXCD, xcd = wgid % NXCD, off = wgid / NXCD; wgid = (xcd < r ? xcd * (q + 1) : r * (q + 1) + (xcd - r) * q) + off; }
        const int nig = WGM * nN, gid = wgid / nig, fm = gid * WGM, gsz = (nM - fm) < WGM ? (nM - fm) : WGM;
        u.pm = fm + ((wgid % nig) % gsz); u.pn = (wgid % nig) / gsz; return true;
    }
    __device__ __forceinline__ void a_ready(const Unit&) const {}
    __device__ __forceinline__ void done(const Unit&) const {}
};

__device__ __forceinline__ unsigned cvt_pk_bf16(float lo, float hi) { unsigned r; asm volatile("v_cvt_pk_bf16_f32 %0, %1, %2" : "=v"(r) : "v"(lo), "v"(hi)); return r; }
typedef float f32x2 __attribute__((ext_vector_type(2)));
__device__ __forceinline__ f32x2 gelu_pk(f32x2 v) {
    const f32x2 av = __builtin_elementwise_abs(v), d = av * 0.2316418882f + 1.0f;
    f32x2 t; t.x = __builtin_amdgcn_rcpf(d.x); t.y = __builtin_amdgcn_rcpf(d.y);
    f32x2 q = t * 0.5307027145f + (-0.7265760135f); q = q * t + 0.7107068705f; q = q * t + (-0.142248368f); q = q * t + 0.127414796f; q = q * t;
    const f32x2 s = (v * v) * (-0.72134752044f);
    f32x2 e; e.x = __builtin_amdgcn_exp2f(s.x); e.y = __builtin_amdgcn_exp2f(s.y);
    const f32x2 m = v * (q * e), r = v - m;
    f32x2 o; o.x = v.x < 0.f ? m.x : r.x; o.y = v.y < 0.f ? m.y : r.y; return o;
}

template <int ACT  > struct EpiBf16 {
    static constexpr bool PERM = true, AFTER_DRAIN = false; static_assert(ACT == 0 || ACT == 1, "EpiBf16: ACT is 0 (none) or 1 (gelu_pk)");
    bf16_t* O; int ldc; const float* bias; int split_cols; size_t split_stride; float scale0;
    __device__ __forceinline__ void operator()(const f32x4 (&acc)[2][2][4][2], const Unit& u, int wr, int wc, int fr, int fq) const {
        const int row0 = u.pm * BM + wr * 64 + fr; int colt = u.pn * BM; bf16_t* base = O;
        float sc = 1.f; if (split_cols) { const int t = colt / split_cols; base += (size_t)t * split_stride; colt -= t * split_cols; if (t == 0) sc = scale0; }
        const int col0 = colt + wc * 32 + 8 * fq, bcol0 = u.pn * BM + wc * 32 + 8 * fq;
        f32x4 bv[2][2];
#pragma unroll
        for (int bj = 0; bj < 2; ++bj)
#pragma unroll
            for (int n = 0; n < 2; ++n) bv[bj][n] = bias ? *(const f32x4*)(bias + bcol0 + bj * HALF + 4 * n) : (f32x4){0.f, 0.f, 0.f, 0.f};
#pragma unroll
        for (int ai = 0; ai < 2; ++ai)
#pragma unroll
            for (int m = 0; m < 4; ++m) { bf16_t* rowp = base + (size_t)(row0 + ai * HALF + m * 16) * ldc + col0;
#pragma unroll
                for (int bj = 0; bj < 2; ++bj) { f32x4 v0 = acc[ai][bj][m][0] + bv[bj][0], v1 = acc[ai][bj][m][1] + bv[bj][1];
                    if (ACT == 1) { f32x2 a = gelu_pk((f32x2){v0[0], v0[1]}), b = gelu_pk((f32x2){v0[2], v0[3]}), c = gelu_pk((f32x2){v1[0], v1[1]}), d = gelu_pk((f32x2){v1[2], v1[3]});
                        v0 = (f32x4){a.x, a.y, b.x, b.y}; v1 = (f32x4){c.x, c.y, d.x, d.y}; }
                    v0 = v0 * sc; v1 = v1 * sc; u32x4 w; w.x = cvt_pk_bf16(v0[0], v0[1]); w.y = cvt_pk_bf16(v0[2], v0[3]); w.z = cvt_pk_bf16(v1[0], v1[1]); w.w = cvt_pk_bf16(v1[2], v1[3]);
                    *(u32x4*)(rowp + bj * HALF) = w; } }
    }
};

struct PanelStats {
    unsigned* xbuf;
    unsigned* cnt;
    unsigned* tmo;
    int ntn; float eps;
    unsigned code;
    __device__ __forceinline__ bool run(const f32x4 (&v)[2][2][4][2], const Unit& u, int wr, int wc, int fr, int fq, PG8_LAS unsigned char* lds, int wid, int lane) const {
        typedef float f32x2v __attribute__((ext_vector_type(2)));
        PG8_LAS f32x2v* P = (PG8_LAS f32x2v*)lds;
        PG8_LAS f32x2v* S = (PG8_LAS f32x2v*)(lds + 8192);
        PG8_LAS unsigned* flag = (PG8_LAS unsigned*)(lds + 8192 + 2048);
#pragma unroll
        for (int ai = 0; ai < 2; ++ai)
#pragma unroll
            for (int m = 0; m < 4; ++m) {
                float s = 0.f;
#pragma unroll
                for (int bj = 0; bj < 2; ++bj)
#pragma unroll
                    for (int n = 0; n < 2; ++n) { const f32x4 x = v[ai][bj][m][n]; s += (x[0] + x[1]) + (x[2] + x[3]); }
                s += __shfl_xor(s, 16); s += __shfl_xor(s, 32);
                const float mw = s * (1.0f / 64.0f); float q = 0.f;
#pragma unroll
                for (int bj = 0; bj < 2; ++bj)
#pragma unroll
                    for (int n = 0; n < 2; ++n) { const f32x4 d = v[ai][bj][m][n] - mw; q += (d[0] * d[0] + d[1] * d[1]) + (d[2] * d[2] + d[3] * d[3]); }
                q += __shfl_xor(q, 16); q += __shfl_xor(q, 32);
                if (fq == 0) P[(ai * HALF + wr * 64 + m * 16 + fr) * 4 + wc] = (f32x2v){mw, q};
            }
        asm volatile("s_waitcnt lgkmcnt(0)" ::: "memory"); __builtin_amdgcn_s_barrier(); asm volatile("" ::: "memory");
#if defined(BROKEN_EXCHANGE_NO_WAIT)
#warning BROKEN CONTROL BUILD: the row-statistics exchange does not wait; results are wrong by design
        if (blockIdx.x >= 64) { const long long t0_ = clock64(); while (clock64() - t0_ < 60000) __builtin_amdgcn_s_sleep(8); }
#endif
        const int row = wid * 32 + (lane & 31);
        if (lane < 32) {
            const f32x2v a = P[row * 4 + 0], b = P[row * 4 + 1], c = P[row * 4 + 2], d = P[row * 4 + 3];
            const float mt = (a.x + b.x + c.x + d.x) * 0.25f;
            const float da = a.x - mt, db = b.x - mt, dc = c.x - mt, dd = d.x - mt;
            const float m2 = (a.y + b.y) + (c.y + d.y) + 64.0f * ((da * da + db * db) + (dc * dc + dd * dd));
            unsigned long long* slot = (unsigned long long*)xbuf + ((size_t)(u.pm * BM + row) * 4 + u.pn);
            __hip_atomic_store(slot, ((unsigned long long)__float_as_uint(m2) << 32) | __float_as_uint(mt), __ATOMIC_RELAXED, __HIP_MEMORY_SCOPE_AGENT);
        }
        asm volatile("s_waitcnt vmcnt(0)" ::: "memory");
        if (lane == 0) __hip_atomic_fetch_add(cnt + 64 * u.pm, 1u, __ATOMIC_RELAXED, __HIP_MEMORY_SCOPE_AGENT);
        if (wid == 0) {
            bool dead = false; const unsigned long long t0 = __builtin_amdgcn_s_memrealtime(); const unsigned want = 8u * (unsigned)ntn;
            for (;;) {
#if defined(BROKEN_EXCHANGE_NO_WAIT)
                break;
#endif
                if ((unsigned)__builtin_amdgcn_readfirstlane(__hip_atomic_load(cnt + 64 * u.pm, __ATOMIC_RELAXED, __HIP_MEMORY_SCOPE_AGENT)) >= want) break;
                if (__builtin_amdgcn_s_memrealtime() - t0 > 2000000ull) {
                    if (lane == 0) { unsigned expect = 0u; __hip_atomic_compare_exchange_strong(tmo + 1, &expect, code | (unsigned)(u.pm & 0xff), __ATOMIC_RELAXED, __ATOMIC_RELAXED, __HIP_MEMORY_SCOPE_AGENT);
                                     __hip_atomic_store(tmo, 1u, __ATOMIC_RELAXED, __HIP_MEMORY_SCOPE_AGENT); }
                    dead = true; break; }
                __builtin_amdgcn_s_sleep(2);
            }
            __builtin_amdgcn_fence(__ATOMIC_ACQUIRE, "agent");
            if (lane == 0) flag[0] = dead ? 1u : 0u;
        }
        asm volatile("s_waitcnt vmcnt(0) lgkmcnt(0)" ::: "memory"); __builtin_amdgcn_s_barrier(); asm volatile("" ::: "memory");
        const bool bad = flag[0] != 0u;
        if (lane < 32) {
            const unsigned long long* slot = (const unsigned long long*)xbuf + (size_t)(u.pm * BM + row) * 4; float mt[4], m2[4]; float ms = 0.f;
#pragma unroll
            for (int t = 0; t < 4; ++t) { if (t < ntn) { const unsigned long long w = __hip_atomic_load(slot + t, __ATOMIC_RELAXED, __HIP_MEMORY_SCOPE_AGENT); mt[t] = __uint_as_float((unsigned)w); m2[t] = __uint_as_float((unsigned)(w >> 32)); } else { mt[t] = 0.f; m2[t] = 0.f; } ms += mt[t]; }
            const float mean = ms / (float)ntn; float q = 0.f;
#pragma unroll
            for (int t = 0; t < 4; ++t) if (t < ntn) { const float dm = mt[t] - mean; q += m2[t] + 256.0f * dm * dm; }
            S[row] = (f32x2v){mean, 1.0f / sqrtf(q / (256.0f * (float)ntn) + eps)};
        }
        asm volatile("s_waitcnt lgkmcnt(0)" ::: "memory"); __builtin_amdgcn_s_barrier(); asm volatile("" ::: "memory");
        return bad;
    }
};
struct EpiLnRes {
    static constexpr bool PERM = false, AFTER_DRAIN = true;
    const float* base; float* out; int ldc; const float* bias; PanelStats st; unsigned poison;
    __device__ __forceinline__ void fused(f32x4 (&acc)[2][2][4][2], const Unit& u, int wr, int wc, int fr, int fq, PG8_LAS unsigned char* lds, int wid, int lane) const {
        typedef float f32x2v __attribute__((ext_vector_type(2)));
        const PG8_LAS f32x2v* S = (const PG8_LAS f32x2v*)(lds + 8192);
        const int col0 = u.pn * BM + wc * 32 + 4 * fq;
#pragma unroll
        for (int bj = 0; bj < 2; ++bj)
#pragma unroll
            for (int n = 0; n < 2; ++n) { const f32x4 bv = bias ? *(const f32x4*)(bias + col0 + bj * HALF + n * 16) : (f32x4){0.f, 0.f, 0.f, 0.f};
#pragma unroll
                for (int ai = 0; ai < 2; ++ai)
#pragma unroll
                    for (int m = 0; m < 4; ++m) acc[ai][bj][m][n] += bv; }
        f32x4 pre[4][2][2];
#pragma unroll
        for (int m = 0; m < 4; ++m) { const size_t off = (size_t)(u.pm * BM + wr * 64 + m * 16 + fr) * ldc + col0;
#pragma unroll
            for (int bj = 0; bj < 2; ++bj)
#pragma unroll
                for (int n = 0; n < 2; ++n) pre[m][bj][n] = *(const f32x4*)(base + off + bj * HALF + n * 16); }
        const bool bad = st.run(acc, u, wr, wc, fr, fq, lds, wid, lane) || poison != 0u;
        const float qnan = __builtin_nanf("");
#pragma unroll
        for (int ai = 0; ai < 2; ++ai)
#pragma unroll
            for (int m = 0; m < 4; ++m) { const int r = ai * HALF + wr * 64 + m * 16 + fr; const f32x2v sr = S[r]; const size_t off = (size_t)(u.pm * BM + r) * ldc + col0;
#pragma unroll
                for (int bj = 0; bj < 2; ++bj)
#pragma unroll
                    for (int n = 0; n < 2; ++n) { const f32x4 bs = ai == 0 ? pre[m][bj][n] : *(const f32x4*)(base + off + bj * HALF + n * 16); f32x4 o = bs + (acc[ai][bj][m][n] - sr.x) * sr.y;
                        if (bad) o = (f32x4){qnan, qnan, qnan, qnan}; *(f32x4*)(out + off + bj * HALF + n * 16) = o; }
                if (m & 1) asm volatile("" ::: "memory"); }
    }
};
struct EpiLnResLn {
    static constexpr bool PERM = false, AFTER_DRAIN = true;
    const float* base; float* out; bf16_t* xn; int ldc; const float* bias; PanelStats st1, st2; unsigned poison;
    __device__ __forceinline__ void fused(f32x4 (&acc)[2][2][4][2], const Unit& u, int wr, int wc, int fr, int fq, PG8_LAS unsigned char* lds, int wid, int lane) const {
        typedef float f32x2v __attribute__((ext_vector_type(2))); typedef unsigned u32x2v __attribute__((ext_vector_type(2)));
        const PG8_LAS f32x2v* S = (const PG8_LAS f32x2v*)(lds + 8192);
        const int col0 = u.pn * BM + wc * 32 + 4 * fq;
#pragma unroll
        for (int bj = 0; bj < 2; ++bj)
#pragma unroll
            for (int n = 0; n < 2; ++n) { const f32x4 bv = bias ? *(const f32x4*)(bias + col0 + bj * HALF + n * 16) : (f32x4){0.f, 0.f, 0.f, 0.f};
#pragma unroll
                for (int ai = 0; ai < 2; ++ai)
#pragma unroll
                    for (int m = 0; m < 4; ++m) acc[ai][bj][m][n] += bv; }
        bool bad = st1.run(acc, u, wr, wc, fr, fq, lds, wid, lane) || poison != 0u;
        const float qnan = __builtin_nanf("");
#pragma unroll
        for (int ai = 0; ai < 2; ++ai)
#pragma unroll
            for (int m = 0; m < 4; ++m) { const int r = ai * HALF + wr * 64 + m * 16 + fr; const f32x2v sr = S[r]; const size_t off = (size_t)(u.pm * BM + r) * ldc + col0;
#pragma unroll
                for (int bj = 0; bj < 2; ++bj)
#pragma unroll
                    for (int n = 0; n < 2; ++n) { const f32x4 bs = *(const f32x4*)(base + off + bj * HALF + n * 16); acc[ai][bj][m][n] = bs + (acc[ai][bj][m][n] - sr.x) * sr.y; }
                asm volatile("" : "+v"(acc[ai][0][m][0]), "+v"(acc[ai][0][m][1]), "+v"(acc[ai][1][m][0]), "+v"(acc[ai][1][m][1]));
                if (m & 1) asm volatile("" ::: "memory"); }
        const bool bad1 = bad;
        bad = st2.run(acc, u, wr, wc, fr, fq, lds, wid, lane) || bad;
#pragma unroll
        for (int ai = 0; ai < 2; ++ai)
#pragma unroll
            for (int m = 0; m < 4; ++m) { const int r = ai * HALF + wr * 64 + m * 16 + fr; const f32x2v sr = S[r]; const size_t off = (size_t)(u.pm * BM + r) * ldc + col0;
#pragma unroll
                for (int bj = 0; bj < 2; ++bj)
#pragma unroll
                    for (int n = 0; n < 2; ++n) { const f32x4 x1 = acc[ai][bj][m][n]; *(f32x4*)(out + off + bj * HALF + n * 16) = bad1 ? (f32x4){qnan, qnan, qnan, qnan} : x1;
                        const f32x4 o = (x1 - sr.x) * sr.y; u32x2v w; w.x = cvt_pk_bf16(o[0], o[1]); w.y = cvt_pk_bf16(o[2], o[3]);
                        if (bad) { w.x = 0x7fc07fc0u; w.y = 0x7fc07fc0u; } *(u32x2v*)(xn + off + bj * HALF + n * 16) = w; }
                asm volatile("" ::: "memory"); }
    }
};

template <class Epi, class Sched, bool ALIGN_EPI = false, bool SP2 = false>
__device__ __forceinline__ void gemm_phase(PG8_LAS unsigned char* lds, const Gemm g, const Sched& S, const Epi& E) {
    const int tid = threadIdx.x, wid = __builtin_amdgcn_readfirstlane(tid >> 6), lane = tid & 63, wr = wid >> 2, wc = wid & 3, fr = lane & 15, fq = lane >> 4;
    const int K = g.K, nt = K / BK;
    unsigned voffA[2], voffB[2];
#pragma unroll
    for (int i = 0; i < 2; ++i) { int R, C; stage_rc(tid * 16 + i * 8192, R, C); const int Rb = Epi::PERM ? ((R & ~31) + perm32(R & 31)) : R;
        voffA[i] = (unsigned)(R * K + C) * 2u; voffB[i] = (unsigned)(Rb * K + C) * 2u; }
    const size_t kstep = (size_t)(BK * 2);
    const size_t hstep = (size_t)HALF * K * 2;
    const size_t tstep = 2 * hstep;
    const unsigned ldsw = (unsigned)wid * 1024u;
    const int aoff = lds_byte(wr * 64 + fr, fq * 8), boff = lds_byte(wc * 32 + fr, fq * 8);
#define PG8_SA(b, h) (((b) * 2 + (h)) * HTB)
#define PG8_SB(b, h) ((4 + (b) * 2 + (h)) * HTB)
#define PG8_STAGE(bufoff, gbase, voff) do { _Pragma("unroll") for (int _i = 0; _i < 2; ++_i) \
        __builtin_amdgcn_global_load_lds((const unsigned*)((const char*)(gbase) + (voff)[_i]), (PG8_LAS unsigned*)(lds + (bufoff) + ldsw + _i * 8192), 16, 0, 0); } while (0)
#define PG8_LDA(dst, b, h) do { _Pragma("unroll") for (int m = 0; m < 4; ++m) _Pragma("unroll") for (int k = 0; k < 2; ++k) dst[m][k] = *(const PG8_LAS bf16x8*)(lds + PG8_SA(b, h) + aoff + m * 2048 + k * 1024); } while (0)
#define PG8_LDB(dst, b, h) do { _Pragma("unroll") for (int n = 0; n < 2; ++n) _Pragma("unroll") for (int k = 0; k < 2; ++k) dst[n][k] = *(const PG8_LAS bf16x8*)(lds + PG8_SB(b, h) + boff + n * 2048 + k * 1024); } while (0)
#define PG8_MMA(ai, bj, At, Bt) do { __builtin_amdgcn_s_setprio(1); _Pragma("unroll") for (int m = 0; m < 4; ++m) _Pragma("unroll") for (int n = 0; n < 2; ++n) _Pragma("unroll") for (int k = 0; k < 2; ++k) \
        acc[ai][bj][m][n] = __builtin_amdgcn_mfma_f32_16x16x32_bf16(Bt[n][k], At[m][k], acc[ai][bj][m][n], 0, 0, 0); __builtin_amdgcn_s_setprio(0); } while (0)
#define PG8_WAIT_V(n) asm volatile("s_waitcnt vmcnt(" #n ")" ::: "memory")
#define PG8_WAIT_L(n) asm volatile("s_waitcnt lgkmcnt(" #n ")" ::: "memory")
#define PG8_BAR __builtin_amdgcn_s_barrier()
#define PG8_SCHED __builtin_amdgcn_sched_barrier(0)
    Unit cur, nxt; int ui = 0;
    if (!S.next(0, cur)) return;
    f32x4 acc[2][2][4][2];
#pragma unroll
    for (int a = 0; a < 2; ++a)
#pragma unroll
        for (int b = 0; b < 2; ++b)
#pragma unroll
            for (int m = 0; m < 4; ++m)
#pragma unroll
                for (int n = 0; n < 2; ++n) acc[a][b][m][n] = (f32x4){0.f, 0.f, 0.f, 0.f};
    bf16x8 At[4][2], B0[2][2], B1[2][2];
    const char* cA = (const char*)g.A + (size_t)cur.pm * tstep; const char* cB = (const char*)g.Bt + (size_t)cur.pn * tstep;
    S.a_ready(cur);
    if constexpr (SP2) {
        PG8_STAGE(PG8_SB(0, 0), cB, voffB); PG8_STAGE(PG8_SB(0, 1), cB + hstep, voffB); PG8_STAGE(PG8_SA(0, 0), cA, voffA); PG8_STAGE(PG8_SA(0, 1), cA + hstep, voffA);
        if (wr == 1) PG8_BAR;
        PG8_WAIT_V(2); PG8_BAR;
        PG8_STAGE(PG8_SB(1, 0), cB + kstep, voffB); PG8_STAGE(PG8_SA(1, 0), cA + kstep, voffA); PG8_STAGE(PG8_SB(1, 1), cB + hstep + kstep, voffB);
        PG8_WAIT_V(6); PG8_BAR;
    } else {
        PG8_STAGE(PG8_SB(0, 0), cB, voffB); PG8_STAGE(PG8_SA(0, 0), cA, voffA); PG8_STAGE(PG8_SB(0, 1), cB + hstep, voffB); PG8_STAGE(PG8_SA(0, 1), cA + hstep, voffA);
        if (wr == 1) PG8_BAR;
        PG8_WAIT_V(4); PG8_BAR;
        PG8_STAGE(PG8_SB(1, 0), cB + kstep, voffB); PG8_STAGE(PG8_SA(1, 0), cA + kstep, voffA); PG8_STAGE(PG8_SB(1, 1), cB + hstep + kstep, voffB);
        PG8_WAIT_V(6); PG8_BAR;
    }
    for (;;) {
        const bool has_next = S.next(ui + 1, nxt);
        const char* nA = has_next ? (const char*)g.A + (size_t)nxt.pm * tstep : cA; const char* nB = has_next ? (const char*)g.Bt + (size_t)nxt.pn * tstep : cB;
        for (int t = 0; t < nt; t += 2) {
            const bool last = (t == nt - 2);
            const char* a1 = cA + (size_t)(t + 1) * kstep;
            const char* a2 = last ? nA : cA + (size_t)(t + 2) * kstep; const char* b2 = last ? nB : cB + (size_t)(t + 2) * kstep;
            const char* a3 = a2 + kstep; const char* b3 = b2 + kstep;
            if (last && has_next) S.a_ready(nxt);
            if constexpr (SP2) {
            PG8_LDB(B0, 0, 0); PG8_LDB(B1, 0, 1); PG8_SCHED; PG8_LDA(At, 0, 0); PG8_STAGE(PG8_SA(1, 1), a1 + hstep, voffA);
            PG8_WAIT_V(8); PG8_WAIT_L(0); PG8_BAR; PG8_MMA(0, 0, At, B0); PG8_MMA(0, 1, At, B1); PG8_BAR; PG8_SCHED;
            PG8_LDA(At, 0, 1); PG8_STAGE(PG8_SB(0, 0), b2, voffB); PG8_STAGE(PG8_SB(0, 1), b2 + hstep, voffB); PG8_STAGE(PG8_SA(0, 0), a2, voffA);
            PG8_WAIT_V(8); PG8_WAIT_L(0); PG8_BAR; PG8_MMA(1, 0, At, B0); PG8_MMA(1, 1, At, B1); PG8_BAR; PG8_SCHED;
            PG8_LDB(B0, 1, 0); PG8_LDB(B1, 1, 1); PG8_SCHED; PG8_LDA(At, 1, 0); PG8_STAGE(PG8_SA(0, 1), a2 + hstep, voffA);
            PG8_WAIT_V(8); PG8_WAIT_L(0); PG8_BAR; PG8_MMA(0, 0, At, B0); PG8_MMA(0, 1, At, B1); PG8_BAR; PG8_SCHED;
            PG8_LDA(At, 1, 1); PG8_STAGE(PG8_SB(1, 0), b3, voffB); PG8_STAGE(PG8_SB(1, 1), b3 + hstep, voffB); PG8_STAGE(PG8_SA(1, 0), a3, voffA);
            PG8_WAIT_V(8); PG8_WAIT_L(0); PG8_BAR; PG8_MMA(1, 0, At, B0); PG8_MMA(1, 1, At, B1); PG8_BAR; PG8_SCHED;
            } else {
            PG8_LDB(B0, 0, 0); PG8_SCHED; PG8_LDA(At, 0, 0); PG8_STAGE(PG8_SA(1, 1), a1 + hstep, voffA);
            PG8_WAIT_L(8); PG8_BAR; PG8_WAIT_L(0); PG8_MMA(0, 0, At, B0); PG8_BAR; PG8_SCHED;
            PG8_LDB(B1, 0, 1); PG8_STAGE(PG8_SB(0, 0), b2, voffB);
            PG8_BAR; PG8_WAIT_L(0); PG8_MMA(0, 1, At, B1); PG8_BAR;
            PG8_LDA(At, 0, 1); PG8_STAGE(PG8_SA(0, 0), a2, voffA);
            PG8_BAR; PG8_WAIT_L(0); PG8_MMA(1, 0, At, B0); PG8_BAR; PG8_SCHED;
            PG8_STAGE(PG8_SB(0, 1), b2 + hstep, voffB);
            PG8_WAIT_V(6); PG8_BAR; PG8_MMA(1, 1, At, B1); PG8_BAR;
            PG8_LDB(B0, 1, 0); PG8_SCHED; PG8_LDA(At, 1, 0); PG8_STAGE(PG8_SA(0, 1), a2 + hstep, voffA);
            PG8_WAIT_L(8); PG8_BAR; PG8_WAIT_L(0); PG8_MMA(0, 0, At, B0); PG8_BAR; PG8_SCHED;
            PG8_LDB(B1, 1, 1); PG8_STAGE(PG8_SB(1, 0), b3, voffB);
            PG8_BAR; PG8_WAIT_L(0); PG8_MMA(0, 1, At, B1); PG8_BAR;
            PG8_LDA(At, 1, 1); PG8_STAGE(PG8_SA(1, 0), a3, voffA);
            PG8_BAR; PG8_WAIT_L(0); PG8_MMA(1, 0, At, B0); PG8_BAR; PG8_SCHED;
            PG8_STAGE(PG8_SB(1, 1), b3 + hstep, voffB);
            PG8_WAIT_V(6); PG8_BAR; PG8_MMA(1, 1, At, B1); PG8_BAR;
            }
        }
        if constexpr (ALIGN_EPI) { if (wr == 0) PG8_BAR; }
        if constexpr (!Epi::AFTER_DRAIN) { E(acc, cur, wr, wc, fr, fq); S.done(cur); }
        if (!has_next) break;
#pragma unroll
        for (int a = 0; a < 2; ++a)
#pragma unroll
            for (int b = 0; b < 2; ++b)
#pragma unroll
                for (int m = 0; m < 4; ++m)
#pragma unroll
                    for (int n = 0; n < 2; ++n) acc[a][b][m][n] = (f32x4){0.f, 0.f, 0.f, 0.f};
        cur = nxt; cA = nA; cB = nB; ++ui;
        if constexpr (ALIGN_EPI) { if (wr == 1) PG8_BAR; }
    }
    PG8_WAIT_V(0);
    if constexpr (!ALIGN_EPI) { if (wr == 0) PG8_BAR; }
    PG8_BAR;
    if constexpr (Epi::AFTER_DRAIN) { E.fused(acc, cur, wr, wc, fr, fq, lds, wid, lane); S.done(cur); }
#undef PG8_SA
#undef PG8_SB
#undef PG8_STAGE
#undef PG8_LDA
#undef PG8_LDB
#undef PG8_MMA
#undef PG8_WAIT_V
#undef PG8_WAIT_L
#undef PG8_BAR
#undef PG8_SCHED
}
}
#ifndef PG8_SP2
#define PG8_SP2 true
#endif
#ifndef PG8_ALIGN
#define PG8_ALIGN true
#endif
namespace pg8 {
__device__ __forceinline__ float gelu_tanh(float x) {
    const float GC1 = -2.3022082f, GC2 = -0.10294324f;
    const float e = __builtin_amdgcn_exp2f(x * (GC1 + GC2 * x * x));
    return x * __builtin_amdgcn_rcpf(1.0f + e);
}
struct EpiProj {
    static constexpr bool PERM = true, AFTER_DRAIN = false;
    bf16_t* O; int ldc; float qscale;
    __device__ __forceinline__ void operator()(const f32x4 (&acc)[2][2][4][2], const Unit& u, int wr, int wc, int fr, int fq) const {
        const int row0 = u.pm * BM + wr * 64 + fr, col0 = u.pn * BM + wc * 32 + 8 * fq;
        const float sc = (u.pn >= 2 && u.pn < 5) ? qscale : 1.f;
#pragma unroll
        for (int ai = 0; ai < 2; ++ai)
#pragma unroll
            for (int m = 0; m < 4; ++m) { bf16_t* rowp = O + (size_t)(row0 + ai * HALF + m * 16) * ldc + col0;
#pragma unroll
                for (int bj = 0; bj < 2; ++bj) { const f32x4 v0 = acc[ai][bj][m][0] * sc, v1 = acc[ai][bj][m][1] * sc;
                    u32x4 w; w.x = cvt_pk_bf16(v0[0], v0[1]); w.y = cvt_pk_bf16(v0[2], v0[3]); w.z = cvt_pk_bf16(v1[0], v1[1]); w.w = cvt_pk_bf16(v1[2], v1[3]);
                    *(u32x4*)(rowp + bj * HALF) = w; } }
    }
};
struct EpiF32 {
    static constexpr bool PERM = false, AFTER_DRAIN = false;
    float* out; int ldc;
    __device__ __forceinline__ void operator()(const f32x4 (&acc)[2][2][4][2], const Unit& u, int wr, int wc, int fr, int fq) const {
        const int col0 = u.pn * BM + wc * 32 + 4 * fq;
#pragma unroll
        for (int ai = 0; ai < 2; ++ai)
#pragma unroll
            for (int m = 0; m < 4; ++m) { const int r = ai * HALF + wr * 64 + m * 16 + fr; const size_t off = (size_t)(u.pm * BM + r) * ldc + col0;
#pragma unroll
                for (int bj = 0; bj < 2; ++bj)
#pragma unroll
                    for (int n = 0; n < 2; ++n) *(f32x4*)(out + off + bj * HALF + n * 16) = acc[ai][bj][m][n]; }
    }
};
__device__ __forceinline__ float dpp_ror1(float v) { return __builtin_bit_cast(float, __builtin_amdgcn_update_dpp(0, __builtin_bit_cast(int, v), 0x121, 0xf, 0xf, true)); }
__device__ __forceinline__ float dpp_ror2(float v) { return __builtin_bit_cast(float, __builtin_amdgcn_update_dpp(0, __builtin_bit_cast(int, v), 0x122, 0xf, 0xf, true)); }
__device__ __forceinline__ float dpp_shr1(float old, float v) { return __builtin_bit_cast(float, __builtin_amdgcn_update_dpp(__builtin_bit_cast(int, old), __builtin_bit_cast(int, v), 0x111, 0xf, 0xf, false)); }
__device__ __forceinline__ float dpp_shr2(float old, float v) { return __builtin_bit_cast(float, __builtin_amdgcn_update_dpp(__builtin_bit_cast(int, old), __builtin_bit_cast(int, v), 0x112, 0xf, 0xf, false)); }
struct EpiGateUp {
    static constexpr bool PERM = true, AFTER_DRAIN = false;
    bf16_t* ACT; int ldc; const float* cw; const float* cb; float* FG; float* FU; float* LG;
    __device__ __forceinline__ void operator()(const f32x4 (&acc)[2][2][4][2], const Unit& u, int wr, int wc, int fr, int fq) const {
        const int gc0 = u.pn * 128 + wc * 32 + 8 * fq;
        f32x4 w0[2], w1[2], w2[2], bb[2];
#pragma unroll
        for (int n = 0; n < 2; ++n) { w0[n] = *(const f32x4*)(cw + gc0 + 4 * n); w1[n] = *(const f32x4*)(cw + ldc + gc0 + 4 * n); w2[n] = *(const f32x4*)(cw + 2 * ldc + gc0 + 4 * n); bb[n] = *(const f32x4*)(cb + gc0 + 4 * n); }
#pragma unroll
        for (int ai = 0; ai < 2; ++ai) {
            const int grp = u.pm * 4 + ai * 2 + wr;
            f32x4 prev[2]; prev[0] = (f32x4){0.f, 0.f, 0.f, 0.f}; prev[1] = prev[0];
#pragma unroll
            for (int m = 0; m < 4; ++m) {
                float a[8];
#pragma unroll
                for (int n = 0; n < 2; ++n) { const f32x4 G = acc[ai][0][m][n], U = acc[ai][1][m][n];
#pragma unroll
                    for (int j = 0; j < 4; ++j) { const float p1 = dpp_shr1(dpp_ror1(prev[n][j]), G[j]), p2 = dpp_shr2(dpp_ror2(prev[n][j]), G[j]);
                        const float cv = bb[n][j] + w2[n][j] * G[j] + w1[n][j] * p1 + w0[n][j] * p2; a[4 * n + j] = gelu_tanh(cv) * U[j]; }
                    if (m == 0 && fr < 2) { *(f32x4*)(FG + (size_t)(grp * 2 + fr) * ldc + gc0 + 4 * n) = G; *(f32x4*)(FU + (size_t)(grp * 2 + fr) * ldc + gc0 + 4 * n) = U; }
                    if (m == 3 && fr >= 14) *(f32x4*)(LG + (size_t)(grp * 2 + fr - 14) * ldc + gc0 + 4 * n) = G;
                    prev[n] = G; }
                u32x4 w; w.x = cvt_pk_bf16(a[0], a[1]); w.y = cvt_pk_bf16(a[2], a[3]); w.z = cvt_pk_bf16(a[4], a[5]); w.w = cvt_pk_bf16(a[6], a[7]);
                *(u32x4*)(ACT + (size_t)(u.pm * BM + ai * HALF + wr * 64 + m * 16 + fr) * ldc + gc0) = w;
            }
        }
    }
};
}
namespace mixer {
#define MX_LAS __attribute__((address_space(3)))
using bf16x8 = __attribute__((ext_vector_type(8))) short;
using s16x4 = __attribute__((ext_vector_type(4))) short;
using f32x16 = __attribute__((ext_vector_type(16))) float;
using f32x4 = __attribute__((ext_vector_type(4))) float;
using u32x4 = __attribute__((ext_vector_type(4))) unsigned;
using u32x2 = __attribute__((ext_vector_type(2))) unsigned;
typedef unsigned short bf16_t;
typedef MX_LAS const char* lds_cptr;
typedef short v4i16_t __attribute__((ext_vector_type(4)));
constexpr int SEQ = 2048, NH = 12, PP = 2816, MP = 1024;
constexpr int COL_U = 0, COL_V = 256, COL_Q = 512, COL_K = 1280, COL_VA = 2048, MIX_B = 256;
constexpr float LOG2E = 1.4426950408889634f, C2 = 0.125f * LOG2E;
constexpr int SLOT = 16384, KOFF = 0, VOFF = 8192, LUTN = 256;
__device__ __forceinline__ float max3f(float a, float b, float c) { return __builtin_fmaxf(__builtin_fmaxf(a, b), c); }
typedef float f32x2_t __attribute__((ext_vector_type(2))); typedef __bf16 bf16x2_t __attribute__((ext_vector_type(2)));
__device__ __forceinline__ unsigned cvtpk(float lo, float hi) { f32x2_t v = {lo, hi}; bf16x2_t b = __builtin_convertvector(v, bf16x2_t); return __builtin_bit_cast(unsigned, b); }
__device__ __forceinline__ float bf2f(unsigned short h) { return __builtin_bit_cast(float, (unsigned)h << 16); }
__device__ __forceinline__ s16x4 vtr(lds_cptr p) { return __builtin_bit_cast(s16x4, __builtin_amdgcn_ds_read_tr16_b64_v4i16((MX_LAS v4i16_t*)p)); }
__device__ __forceinline__ float gelu_tanh(float x) {
    const float e = __builtin_amdgcn_exp2f(x * (-2.3022082f + -0.10294324f * x * x));
    return x * __builtin_amdgcn_rcpf(1.0f + e);
}
__device__ __forceinline__ void dma_tile(MX_LAS char* slot, const bf16_t* kp, const bf16_t* vp, long vstep) {
#pragma unroll
    for (int c = 0; c < 8; ++c) __builtin_amdgcn_global_load_lds((const unsigned*)(kp + 8 * c), (MX_LAS unsigned*)(slot + KOFF + c * 1024), 16, 0, 0);
#pragma unroll
    for (int dh = 0; dh < 2; ++dh)
#pragma unroll
        for (int g = 0; g < 4; ++g) __builtin_amdgcn_global_load_lds((const unsigned*)(vp + g * vstep + dh * 32), (MX_LAS unsigned*)(slot + VOFF + (dh * 4 + g) * 1024), 16, 0, 0);
}
__device__ __forceinline__ void block_tile(f32x16& o0, f32x16& o1, float& m, float& l, const bf16x8 (&qr)[4], lds_cptr kl, lds_cptr vl, const MX_LAS float* lut) {
    f32x16 s0, s1;
#pragma unroll
    for (int r = 0; r < 16; ++r) { s0[r] = lut[(r & 3) + 8 * (r >> 2)]; s1[r] = lut[32 + (r & 3) + 8 * (r >> 2)]; }
#pragma unroll
    for (int d0 = 0; d0 < 4; ++d0) {
        const bf16x8 b0 = *(const MX_LAS bf16x8*)(kl + d0 * 2048), b1 = *(const MX_LAS bf16x8*)(kl + d0 * 2048 + 512);
        s0 = __builtin_amdgcn_mfma_f32_32x32x16_bf16(b0, qr[d0], s0, 0, 0, 0);
        s1 = __builtin_amdgcn_mfma_f32_32x32x16_bf16(b1, qr[d0], s1, 0, 0, 0);
    }
    float a = max3f(s0[0], s0[1], s1[0]), b = max3f(s0[2], s0[3], s1[1]); a = max3f(a, s1[2], s1[3]);
#pragma unroll
    for (int r = 4; r < 16; r += 4) { a = max3f(a, s0[r], s0[r + 1]); b = max3f(b, s0[r + 2], s0[r + 3]); a = max3f(a, s1[r], s1[r + 1]); b = max3f(b, s1[r + 2], s1[r + 3]); }
    float rm = __builtin_fmaxf(a, b);
    { auto rr = __builtin_amdgcn_permlane32_swap(__float_as_uint(rm), __float_as_uint(rm), false, false); rm = __builtin_fmaxf(__uint_as_float(rr[0]), __uint_as_float(rr[1])); }
    const float mn = __builtin_fmaxf(m, rm), alpha = __builtin_amdgcn_exp2f(m - mn); m = mn;
    float ps = 0.f;
#pragma unroll
    for (int r = 0; r < 16; ++r) { s0[r] = __builtin_amdgcn_exp2f(s0[r] - mn); s1[r] = __builtin_amdgcn_exp2f(s1[r] - mn); ps += s0[r] + s1[r]; }
    l = l * alpha + ps;
#pragma unroll
    for (int r = 0; r < 16; ++r) { o0[r] *= alpha; o1[r] *= alpha; }
    u32x4 pw[4];
#pragma unroll
    for (int i = 0; i < 4; ++i) { pw[0][i] = cvtpk(s0[2 * i], s0[2 * i + 1]); pw[1][i] = cvtpk(s0[8 + 2 * i], s0[8 + 2 * i + 1]); pw[2][i] = cvtpk(s1[2 * i], s1[2 * i + 1]); pw[3][i] = cvtpk(s1[8 + 2 * i], s1[8 + 2 * i + 1]); }
#pragma unroll
    for (int ks = 0; ks < 4; ++ks) {
        const s16x4 lo0 = vtr(vl + ks * 1024), hi0 = vtr(vl + ks * 1024 + 512), lo1 = vtr(vl + 4096 + ks * 1024), hi1 = vtr(vl + 4096 + ks * 1024 + 512);
        const bf16x8 v0 = (bf16x8){lo0[0], lo0[1], lo0[2], lo0[3], hi0[0], hi0[1], hi0[2], hi0[3]}, v1 = (bf16x8){lo1[0], lo1[1], lo1[2], lo1[3], hi1[0], hi1[1], hi1[2], hi1[3]};
        const bf16x8 p = __builtin_bit_cast(bf16x8, pw[ks]);
        o0 = __builtin_amdgcn_mfma_f32_32x32x16_bf16(v0, p, o0, 0, 0, 0);
        o1 = __builtin_amdgcn_mfma_f32_32x32x16_bf16(v1, p, o1, 0, 0, 0);
    }
}
struct Tensors { const bf16_t* PROJ; bf16_t* MIX; float* LSE; const float* rel_bias; const bf16_t* WSP; const float* ln_g; const float* ln_b; const float* sp_b; };
#define MX_WAIT_V0() asm volatile("s_waitcnt vmcnt(0)" ::: "memory")
#define MX_WAIT_L0() asm volatile("s_waitcnt lgkmcnt(0)" ::: "memory")

__device__ __forceinline__ void attn_unit(const Tensors& T, int b, int h, int n, MX_LAS char* lds, MX_LAS float* LUT, int wave, int lane) {
    const int r32 = lane & 31, hi = lane >> 5, tid = threadIdx.x;
    __syncthreads();
    for (int i = tid; i < 3 * LUTN; i += 512) {
        const int seg = i >> 8, x = i & 255, rel = 192 - x; float v = -INFINITY;
        if (rel >= 0 && rel <= 128) { const int dist = rel << (2 * seg); int bk = dist;
            if (dist >= 16) { bk = 16 + (int)(__log2f((float)dist * 0.0625f) * (16.0f / 7.0f)); bk = bk > 31 ? 31 : bk; }
            v = T.rel_bias[bk * NH + h] * LOG2E; }
        LUT[i] = v;
    }
    __syncthreads();
    MX_LAS char* slot = lds + wave * SLOT;
    const lds_cptr kl = (lds_cptr)slot + KOFF + hi * 1024 + r32 * 16;
    const lds_cptr vl = (lds_cptr)slot + VOFF + ((lane >> 4) & 1) * 32 + (lane & 3) * 8 + (4 * hi + ((lane & 15) >> 2)) * 64;
    const long rowb = (long)b * SEQ; const int P0 = 512 * n;
    const bf16_t* Kh = T.PROJ + rowb * PP + COL_K + 64 * h; const bf16_t* Vh = T.PROJ + rowb * PP + COL_VA + 64 * h; const bf16_t* Qh = T.PROJ + rowb * PP + COL_Q + 64 * h;
    bf16_t* Mh = T.MIX + rowb * MP + MIX_B + 64 * h; float* Lh = T.LSE + rowb * NH + h;
    {
        bf16x8 qa[4], qb[4];
        const int pa = P0 + 64 * wave + r32, pb = pa + 32;
#pragma unroll
        for (int d0 = 0; d0 < 4; ++d0) { qa[d0] = *(const bf16x8*)(Qh + (long)pa * PP + d0 * 16 + hi * 8); qb[d0] = *(const bf16x8*)(Qh + (long)pb * PP + d0 * 16 + hi * 8); }
        f32x16 oa0 = {}, oa1 = {}, ob0 = {}, ob1 = {}; float ma = -1e30f, la = 0.f, mb = -1e30f, lb = 0.f;
#pragma unroll 1
        for (int a = 0; a < 3; ++a) {
            const int k0 = P0 + 64 * wave - 128 + 64 * a; if (k0 < 0) continue;
            MX_WAIT_L0();
            dma_tile(slot, Kh + (long)(k0 + lane) * PP, Vh + (long)(k0 + (lane >> 2)) * PP + (lane & 3) * 8, 16L * PP);
            MX_WAIT_V0();
            const int xa = 64 + 64 * a - r32 + 4 * hi, xb = xa - 32;
            block_tile(oa0, oa1, ma, la, qa, kl, vl, LUT + xa);
            __builtin_amdgcn_sched_barrier(0);
            block_tile(ob0, ob1, mb, lb, qb, kl, vl, LUT + xb);
        }
#define MX_EPI_A(o0_, o1_, m_, l_, p_) do { float lt = l_; { auto rr = __builtin_amdgcn_permlane32_swap(__float_as_uint(lt), __float_as_uint(lt), false, false); lt = __uint_as_float(rr[0]) + __uint_as_float(rr[1]); } \
            const float il = __builtin_amdgcn_rcpf(lt); bf16_t* mrow = Mh + (long)(p_) * MP + 4 * hi; \
            _Pragma("unroll") for (int rq = 0; rq < 4; ++rq) { u32x2 w0, w1; w0.x = cvtpk(o0_[4 * rq] * il, o0_[4 * rq + 1] * il); w0.y = cvtpk(o0_[4 * rq + 2] * il, o0_[4 * rq + 3] * il); \
                w1.x = cvtpk(o1_[4 * rq] * il, o1_[4 * rq + 1] * il); w1.y = cvtpk(o1_[4 * rq + 2] * il, o1_[4 * rq + 3] * il); *(u32x2*)(mrow + 8 * rq) = w0; *(u32x2*)(mrow + 32 + 8 * rq) = w1; } \
            if (hi == 0) Lh[(long)(p_) * NH] = m_ + __log2f(lt); } while (0)
        MX_EPI_A(oa0, oa1, ma, la, pa);
        MX_EPI_A(ob0, ob1, mb, lb, pb);
#undef MX_EPI_A
    }
    MX_WAIT_V0(); MX_WAIT_L0();
    __syncthreads();
    {
        const int ra = wave, rb = wave + 8, c4 = wave & 3;
        const int pa = P0 + 16 * r32 + ra, pb = P0 + 16 * r32 + rb;
        bf16x8 qa[4], qb[4];
#pragma unroll
        for (int d0 = 0; d0 < 4; ++d0) { qa[d0] = *(const bf16x8*)(Qh + (long)pa * PP + d0 * 16 + hi * 8); qb[d0] = *(const bf16x8*)(Qh + (long)pb * PP + d0 * 16 + hi * 8); }
        f32x16 oa0 = {}, oa1 = {}, ob0 = {}, ob1 = {}; float ma = -1e30f, la = 0.f, mb = -1e30f, lb = 0.f;
#pragma unroll 1
        for (int a = 0; a < 4; ++a) {
            const int jk0 = 128 * (n - 1) + 64 * a; if (jk0 < 0) continue;
            MX_WAIT_L0();
            dma_tile(slot, Kh + (long)(4 * (jk0 + lane) + c4) * PP, Vh + (long)(4 * (jk0 + (lane >> 2)) + c4) * PP + (lane & 3) * 8, 64L * PP);
            MX_WAIT_V0();
            int xa = 64 + 64 * a - (ra >> 2) - 4 * r32 + 4 * hi, xb = 64 + 64 * a - (rb >> 2) - 4 * r32 + 4 * hi;
            xa = xa < 0 ? 0 : (xa > 196 ? 196 : xa); xb = xb < 0 ? 0 : (xb > 196 ? 196 : xb);
            block_tile(oa0, oa1, ma, la, qa, kl, vl, LUT + LUTN + xa);
            __builtin_amdgcn_sched_barrier(0);
            block_tile(ob0, ob1, mb, lb, qb, kl, vl, LUT + LUTN + xb);
        }
#pragma unroll 1
        for (int a = 0; a <= (n >> 1); ++a) {
            const int x3 = 192 - 32 * n + 64 * a - r32 + 4 * hi;
            MX_WAIT_L0();
            dma_tile(slot, Kh + (long)(16 * (64 * a + lane) + ra) * PP, Vh + (long)(16 * (64 * a + (lane >> 2)) + ra) * PP + (lane & 3) * 8, 256L * PP);
            MX_WAIT_V0();
            block_tile(oa0, oa1, ma, la, qa, kl, vl, LUT + 2 * LUTN + x3);
            MX_WAIT_L0();
            dma_tile(slot, Kh + (long)(16 * (64 * a + lane) + rb) * PP, Vh + (long)(16 * (64 * a + (lane >> 2)) + rb) * PP + (lane & 3) * 8, 256L * PP);
            MX_WAIT_V0();
            block_tile(ob0, ob1, mb, lb, qb, kl, vl, LUT + 2 * LUTN + x3);
        }
#define MX_EPI_B(o0_, o1_, m_, l_, p_) do { float lt = l_; { auto rr = __builtin_amdgcn_permlane32_swap(__float_as_uint(lt), __float_as_uint(lt), false, false); lt = __uint_as_float(rr[0]) + __uint_as_float(rr[1]); } \
            const float lse2 = m_ + __log2f(lt), lse1 = Lh[(long)(p_) * NH], mm = __builtin_fmaxf(lse1, lse2), e1 = __builtin_amdgcn_exp2f(lse1 - mm), e2 = __builtin_amdgcn_exp2f(lse2 - mm); \
            const float id = __builtin_amdgcn_rcpf(e1 + e2), w1 = e1 * id, w2 = e2 * id * __builtin_amdgcn_rcpf(lt); bf16_t* mrow = Mh + (long)(p_) * MP + 4 * hi; \
            _Pragma("unroll") for (int rq = 0; rq < 4; ++rq) { const u32x2 a0 = *(const u32x2*)(mrow + 8 * rq), a1 = *(const u32x2*)(mrow + 32 + 8 * rq); u32x2 w0, w1_; \
                w0.x = cvtpk(w1 * bf2f(a0.x & 0xffff) + w2 * o0_[4 * rq], w1 * bf2f(a0.x >> 16) + w2 * o0_[4 * rq + 1]); w0.y = cvtpk(w1 * bf2f(a0.y & 0xffff) + w2 * o0_[4 * rq + 2], w1 * bf2f(a0.y >> 16) + w2 * o0_[4 * rq + 3]); \
                w1_.x = cvtpk(w1 * bf2f(a1.x & 0xffff) + w2 * o1_[4 * rq], w1 * bf2f(a1.x >> 16) + w2 * o1_[4 * rq + 1]); w1_.y = cvtpk(w1 * bf2f(a1.y & 0xffff) + w2 * o1_[4 * rq + 2], w1 * bf2f(a1.y >> 16) + w2 * o1_[4 * rq + 3]); \
                *(u32x2*)(mrow + 8 * rq) = w0; *(u32x2*)(mrow + 32 + 8 * rq) = w1_; } } while (0)
        MX_EPI_B(oa0, oa1, ma, la, pa);
        MX_EPI_B(ob0, ob1, mb, lb, pb);
#undef MX_EPI_B
    }
    MX_WAIT_L0();
}

__device__ __forceinline__ void gmlp_unit(const Tensors& T, int b, int ch, int g, MX_LAS char* slot, int lane) {
    const int r32 = lane & 31, hi = lane >> 5;
    const long t0 = (long)b * SEQ + 128 * ch;
    const float* lg = T.ln_g + 64 * g; const float* lb = T.ln_b + 64 * g;
    MX_WAIT_L0();
#pragma unroll 1
    for (int tk = 0; tk < 2; ++tk) {
        const int s = lane + 64 * tk; const bf16_t* vrow = T.PROJ + (t0 + s) * PP + COL_V + 64 * g;
        float x[64]; float sum = 0.f;
#pragma unroll
        for (int c = 0; c < 8; ++c) { const u32x4 w = *(const u32x4*)(vrow + 8 * c);
#pragma unroll
            for (int j = 0; j < 4; ++j) { const float lo = gelu_tanh(bf2f(w[j] & 0xffff)), hh = gelu_tanh(bf2f(w[j] >> 16)); x[8 * c + 2 * j] = lo; x[8 * c + 2 * j + 1] = hh; sum += lo + hh; } }
        const float mu = sum * (1.f / 64.f); float q = 0.f;
#pragma unroll
        for (int d = 0; d < 64; ++d) { x[d] -= mu; q += x[d] * x[d]; }
        const float rstd = __builtin_amdgcn_rsqf(q * (1.f / 64.f) + 1e-6f);
#pragma unroll
        for (int d = 0; d < 64; ++d) { const float vn = x[d] * rstd * lg[d] + lb[d];
            *(MX_LAS unsigned short*)(slot + d * 256 + ((((s >> 3) ^ (d & 15))) << 4) + (s & 7) * 2) = (unsigned short)(cvtpk(vn, vn) & 0xffff); }
    }
    MX_WAIT_L0();
    const bf16_t* W = T.WSP + (long)g * 128 * 128;
#pragma unroll 1
    for (int tt = 0; tt < 4; ++tt) {
        f32x16 z0 = {}, z1 = {};
        const bf16_t* wrow = W + (32 * tt + r32) * 128 + 8 * hi;
        for (int ks = 0; ks <= 2 * tt + 1; ++ks) {
            const bf16x8 bw = *(const bf16x8*)(wrow + 16 * ks);
            const bf16x8 a0 = *(const MX_LAS bf16x8*)(slot + r32 * 256 + (((2 * ks + hi) ^ (r32 & 15)) << 4));
            const bf16x8 a1 = *(const MX_LAS bf16x8*)(slot + (32 + r32) * 256 + (((2 * ks + hi) ^ (r32 & 15)) << 4));
            z0 = __builtin_amdgcn_mfma_f32_32x32x16_bf16(a0, bw, z0, 0, 0, 0);
            z1 = __builtin_amdgcn_mfma_f32_32x32x16_bf16(a1, bw, z1, 0, 0, 0);
        }
        const int t = 32 * tt + r32; const float bs = T.sp_b[g * 128 + t];
        const bf16_t* urow = T.PROJ + (t0 + t) * PP + COL_U + 64 * g + 4 * hi; bf16_t* orow = T.MIX + (t0 + t) * MP + 64 * g + 4 * hi;
#pragma unroll
        for (int rq = 0; rq < 4; ++rq) { const u32x2 u0 = *(const u32x2*)(urow + 8 * rq), u1 = *(const u32x2*)(urow + 32 + 8 * rq); u32x2 w0, w1;
            w0.x = cvtpk(gelu_tanh(bf2f(u0.x & 0xffff)) * (z0[4 * rq] + bs), gelu_tanh(bf2f(u0.x >> 16)) * (z0[4 * rq + 1] + bs)); w0.y = cvtpk(gelu_tanh(bf2f(u0.y & 0xffff)) * (z0[4 * rq + 2] + bs), gelu_tanh(bf2f(u0.y >> 16)) * (z0[4 * rq + 3] + bs));
            w1.x = cvtpk(gelu_tanh(bf2f(u1.x & 0xffff)) * (z1[4 * rq] + bs), gelu_tanh(bf2f(u1.x >> 16)) * (z1[4 * rq + 1] + bs)); w1.y = cvtpk(gelu_tanh(bf2f(u1.y & 0xffff)) * (z1[4 * rq + 2] + bs), gelu_tanh(bf2f(u1.y >> 16)) * (z1[4 * rq + 3] + bs));
            *(u32x2*)(orow + 8 * rq) = w0; *(u32x2*)(orow + 32 + 8 * rq) = w1; }
    }
    MX_WAIT_L0();
}
}
constexpr int NWAVES = 8;
#ifndef MK_N_LAUNCHES
#define MK_N_LAUNCHES 1
#endif
constexpr int N_PHASES = 9;
constexpr int N_LAUNCHES = MK_N_LAUNCHES;

constexpr int BATCH = 16, T = 2048, D = 1024, NIN = 2816, FF = 2816, NGU = 2 * FF;
constexpr int M = BATCH * T;
constexpr float EPS = 1e-6f;

constexpr size_t MiB = 1u << 20;
constexpr size_t WS_CTL = 0, CTL_ZERO_BYTES = 1 * MiB;
constexpr size_t WS_WIN = 2 * MiB, WS_WOUT = 8 * MiB, WS_WGU = 10 * MiB, WS_WDN = 21 * MiB, WS_WSP = 27 * MiB;
constexpr size_t WS_LSE = 28 * MiB;
constexpr size_t WS_FG = 32 * MiB, WS_FU = 44 * MiB, WS_LG = 56 * MiB;
constexpr size_t WS_XN = 68 * MiB;
constexpr size_t WS_PROJ = 132 * MiB;
constexpr size_t WS_ACT = WS_PROJ;
constexpr size_t WS_MIX = 308 * MiB;
constexpr size_t WS_Y = 372 * MiB, WS_END = 500 * MiB;
static_assert(WS_WIN + (size_t)NIN * D * 2 <= WS_WOUT && WS_WOUT + (size_t)D * D * 2 <= WS_WGU && WS_WGU + (size_t)NGU * D * 2 <= WS_WDN && WS_WDN + (size_t)D * FF * 2 <= WS_WSP && WS_WSP + 4 * 128 * 128 * 2 <= WS_LSE, "ws map (weights)");
static_assert(WS_LSE + (size_t)M * 12 * 4 <= WS_FG && WS_FG + (size_t)(M / 64) * 2 * FF * 4 <= WS_FU && WS_LG + (size_t)(M / 64) * 2 * FF * 4 <= WS_XN && WS_XN + (size_t)M * D * 2 <= WS_PROJ && WS_PROJ + (size_t)M * NIN * 2 <= WS_MIX && WS_MIX + (size_t)M * D * 2 <= WS_Y && WS_Y + (size_t)M * D * 4 <= WS_END, "ws map");
constexpr int CW_TMO = 0, CW_CODE = 1;
constexpr int CW_BAR = 4096;

constexpr int RING_OFF = 0, RING_BYTES = 131072;
constexpr int LUT_OFF = RING_BYTES, LUT_BYTES = 3 * 256 * 4;
constexpr int LDSCTL_OFF = LUT_OFF + LUT_BYTES, MISC_OFF = LDSCTL_OFF + 320;
constexpr int LDS_BYTES = 147456;
static_assert(MISC_OFF + 128 <= LDS_BYTES, "LDS map");

#define GAS __attribute__((address_space(1)))
#define LAS __attribute__((address_space(3)))
typedef unsigned short bf16;
typedef unsigned v4u __attribute__((ext_vector_type(4)));
typedef float f32x4 __attribute__((ext_vector_type(4)));
typedef short bf16x8 __attribute__((ext_vector_type(8)));
typedef GAS unsigned gu32;
typedef GAS unsigned long long gu64;
#define RLX_AGENT __ATOMIC_RELAXED, __HIP_MEMORY_SCOPE_AGENT
#define LDS_WAIT() asm volatile("s_waitcnt lgkmcnt(0)" ::: "memory")
#define VM_WAIT() asm volatile("s_waitcnt vmcnt(0)" ::: "memory")
__device__ __forceinline__ unsigned long long rt() { return __builtin_amdgcn_s_memrealtime(); }
__device__ __forceinline__ unsigned f2bf(float f) { unsigned u = __builtin_bit_cast(unsigned, f); return (u + 0x7fffu + ((u >> 16) & 1u)) >> 16; }
__device__ __forceinline__ unsigned pk2(float lo, float hi) { return f2bf(lo) | (f2bf(hi) << 16); }

#define XB_TMO      128
#define XB_XCNT(j)  (256  + 64 * (j))
#define XB_XSUB(j)  (1280 + 64 * (j))
#define XB_XGEN(j)  (2304 + 64 * (j))
#define XB_TOP      3328
#define XB_TOPGEN   3392
#define XCD_BAR_WORDS 3456
#define XB_SPIN_CAP (1u << 18)

__device__ __forceinline__ unsigned xb_ld(unsigned* p)              { return __hip_atomic_load(p, __ATOMIC_RELAXED, __HIP_MEMORY_SCOPE_AGENT); }
__device__ __forceinline__ unsigned xb_add(unsigned* p, unsigned v) { return __hip_atomic_fetch_add(p, v, __ATOMIC_RELAXED, __HIP_MEMORY_SCOPE_AGENT); }
__device__ __forceinline__ unsigned xb_xcc_id() { return (unsigned)__builtin_amdgcn_s_getreg((3 << 11) | 20) & 0xFu; }
#define XB_SPIN(cond, bar) do { unsigned _sp = 0; while (cond) { __builtin_amdgcn_s_sleep(1); \
    if ((++_sp & 255u) == 0u) { if (xb_ld(&(bar)[XB_TMO])) break; if (_sp > XB_SPIN_CAP) { atomicAdd(&(bar)[XB_TMO], 1u); break; } } } } while (0)

struct XcdBarrier {
    unsigned* bar; unsigned x;
    volatile LAS unsigned* st;
};

__device__ __forceinline__ XcdBarrier xcd_barrier_post(unsigned* bar, volatile LAS unsigned* st) {
    XcdBarrier b; b.bar = bar; b.x = xb_xcc_id(); b.st = st;
    if (threadIdx.x == 0) (void)xb_add(&bar[XB_XCNT(b.x)], 1u);
    return b;
}
__device__ __forceinline__ void xcd_barrier_complete(unsigned* bar, unsigned x, unsigned& nloc, unsigned& nx) {
    const unsigned G = gridDim.x * gridDim.y * gridDim.z;
    unsigned sum, cnt, mine, sp = 0u;
    for (;;) {
        sum = 0u; cnt = 0u; mine = 0u;
#pragma unroll
        for (unsigned j = 0; j < 16; ++j) { const unsigned c = xb_ld(&bar[XB_XCNT(j)]); sum += c; cnt += (c > 0u) ? 1u : 0u; mine = (j == x) ? c : mine; }
        if (sum == G) break;
        __builtin_amdgcn_s_sleep(1);
        if ((++sp & 255u) == 0u) { if (xb_ld(&bar[XB_TMO])) break; if (sp > XB_SPIN_CAP) { atomicAdd(&bar[XB_TMO], 1u); break; } }
    }
    nloc = mine > 0u ? mine : 1u; nx = cnt > 0u ? cnt : 1u;
}

__device__ __forceinline__ void xcd_barrier(const XcdBarrier& b) {
    asm volatile("s_waitcnt vmcnt(0)" ::: "memory");
    __syncthreads();
    if (threadIdx.x == 0) {
        unsigned* bar = b.bar;
        __builtin_amdgcn_s_waitcnt(0);
        unsigned nloc = b.st[0], nx = b.st[1];
        if (nloc == 0u) { xcd_barrier_complete(bar, b.x, nloc, nx); b.st[0] = nloc; b.st[1] = nx; }
        const unsigned old = xb_add(&bar[XB_XSUB(b.x)], 1u);
        const unsigned gen = old / nloc;
        if (old + 1u == (gen + 1u) * nloc) {
            __builtin_amdgcn_fence(__ATOMIC_RELEASE, "agent");
            asm volatile("s_waitcnt vmcnt(0)" ::: "memory");
            const unsigned og = xb_add(&bar[XB_TOP], 1u);
            const unsigned tg = og / nx;
            if (og + 1u == (tg + 1u) * nx) xb_add(&bar[XB_TOPGEN], 1u);
            else XB_SPIN(xb_ld(&bar[XB_TOPGEN]) == tg, bar);
            __builtin_amdgcn_fence(__ATOMIC_ACQUIRE, "agent");
            xb_add(&bar[XB_XGEN(b.x)], 1u);
            asm volatile("s_waitcnt vmcnt(0)" ::: "memory");
        } else {
            XB_SPIN(xb_ld(&bar[XB_XGEN(b.x)]) == gen, bar);
            __builtin_amdgcn_fence(__ATOMIC_ACQUIRE, "agent");
            asm volatile("s_waitcnt vmcnt(0)" ::: "memory");
        }
    }
    __syncthreads();
}


struct Frame {
    LAS unsigned char* lds;
    volatile LAS unsigned* MISC;
    gu32* ctl;
    int tid, lane, wave;
    int vcu, G;
};

__device__ __forceinline__ float wave_sum(float v) {
#pragma unroll
    for (int o = 1; o < 64; o <<= 1) v += __shfl_xor(v, o);
    return v;
}
__device__ __forceinline__ void p0_transpose_item(const float* W, int K, int N, bf16* WT, int k0, int n0, int drow0, LAS float* scr, int lane) {
#pragma unroll 8
    for (int i = 0; i < 32; ++i) { const int kk = 2 * i + (lane >> 5); scr[kk * 33 + (lane & 31)] = W[(size_t)(k0 + kk) * N + n0 + (lane & 31)]; }
    LDS_WAIT(); asm volatile("" ::: "memory");
    const int c = lane & 7;
#pragma unroll
    for (int j = 0; j < 4; ++j) { const int n = (lane >> 3) + 8 * j; const LAS float* s = scr + (8 * c) * 33 + n;
        v4u o; o.x = pk2(s[0 * 33], s[1 * 33]); o.y = pk2(s[2 * 33], s[3 * 33]); o.z = pk2(s[4 * 33], s[5 * 33]); o.w = pk2(s[6 * 33], s[7 * 33]);
        *(GAS v4u*)(WT + (size_t)(drow0 + n) * K + k0 + 8 * c) = o; }
    LDS_WAIT(); asm volatile("" ::: "memory");
}
__device__ __forceinline__ void rms_row_to_bf16(int lane, const float* xrow, const float* g, bf16* orow) {
    const GAS f32x4* xr = (const GAS f32x4*)xrow + lane; const GAS f32x4* gr = (const GAS f32x4*)g + lane;
    f32x4 v[4]; float s = 0.f;
#pragma unroll
    for (int j = 0; j < 4; ++j) { v[j] = xr[64 * j]; s += (v[j].x * v[j].x + v[j].y * v[j].y) + (v[j].z * v[j].z + v[j].w * v[j].w); }
    const float r = 1.f / sqrtf(wave_sum(s) * (1.f / D) + EPS);
    GAS unsigned long long* o8 = (GAS unsigned long long*)orow + lane;
#pragma unroll
    for (int j = 0; j < 4; ++j) { const f32x4 gg = gr[64 * j]; o8[64 * j] = (unsigned long long)pk2(v[j].x * r * gg.x, v[j].y * r * gg.y) | ((unsigned long long)pk2(v[j].z * r * gg.z, v[j].w * r * gg.w) << 32); }
}

struct Args { const float* in[17]; float* out; unsigned char* ws; int ph_lo, ph_hi, li, pad; };

__global__ void __launch_bounds__(NWAVES * 64, 2) mk_fwd(Args args) {
    extern __shared__ __attribute__((aligned(16))) unsigned char lds[];
    Frame F;
    F.lds = (LAS unsigned char*)lds;
    F.MISC = (volatile LAS unsigned*)(F.lds + MISC_OFF);
    F.tid = threadIdx.x; F.lane = F.tid & 63; F.wave = __builtin_amdgcn_readfirstlane(F.tid >> 6);
    F.G = gridDim.x; { const int bx = blockIdx.x; F.vcu = (F.G % 8 == 0) ? (bx % 8) * (F.G / 8) + bx / 8 : bx; }
    unsigned char* ws = args.ws;
    F.ctl = (gu32*)(ws + WS_CTL);
    const float* x = args.in[0]; const float* g_mix_pre = args.in[1]; const float* g_mix_post = args.in[2]; const float* g_ffn_pre = args.in[3]; const float* g_ffn_post = args.in[4];
    const float* w_in = args.in[5]; const float* ln_g = args.in[6]; const float* ln_b = args.in[7]; const float* sp_w = args.in[8]; const float* sp_b = args.in[9]; const float* rel_bias = args.in[10];
    const float* w_out = args.in[11]; const float* w_gate = args.in[12]; const float* w_up = args.in[13]; const float* conv_w = args.in[14]; const float* conv_b = args.in[15]; const float* w_down = args.in[16];
    float* out = args.out;
    bf16* Win_t = (bf16*)(ws + WS_WIN); bf16* Wout_t = (bf16*)(ws + WS_WOUT); bf16* Wgu_t = (bf16*)(ws + WS_WGU); bf16* Wdn_t = (bf16*)(ws + WS_WDN); bf16* Wsp = (bf16*)(ws + WS_WSP);
    bf16* XN = (bf16*)(ws + WS_XN); bf16* PROJ = (bf16*)(ws + WS_PROJ); bf16* ACT = (bf16*)(ws + WS_ACT); bf16* MIX = (bf16*)(ws + WS_MIX);
    float* Y = (float*)(ws + WS_Y); float* LSE = (float*)(ws + WS_LSE); float* FG = (float*)(ws + WS_FG); float* FU = (float*)(ws + WS_FU); float* LG = (float*)(ws + WS_LG);

    for (int u = F.tid; u < (LDS_BYTES - LDSCTL_OFF) / 4; u += NWAVES * 64) ((LAS unsigned*)(F.lds + LDSCTL_OFF))[u] = 0u;
    __syncthreads();
    XcdBarrier bar; bar.bar = (unsigned*)(F.ctl + CW_BAR); bar.x = 0; bar.st = nullptr;
    if (N_LAUNCHES == 1) bar = xcd_barrier_post((unsigned*)(F.ctl + CW_BAR), F.MISC + 8);
#define GRID_BAR() do { if (N_LAUNCHES == 1) xcd_barrier(bar); } while (0)
    const int lo = args.ph_lo, hi = args.ph_hi;
#ifndef PHASE_MASK
#define PHASE_MASK 0x1ff
#endif
#define IN(k) (((PHASE_MASK >> (k)) & 1) && lo <= (k) && (k) < hi)
    const int gw = F.vcu * NWAVES + F.wave, NGW = F.G * NWAVES;

    if (IN(0)) {
        LAS float* scr = (LAS float*)(F.lds + RING_OFF + F.wave * 16384);
        constexpr int NB_IN = NIN / 32, NB_D = D / 32, NB_FF = FF / 32;
        constexpr int I_IN = (D / 64) * NB_IN, I_OUT = (D / 64) * NB_D, I_G = (D / 64) * NB_FF, I_DN = (FF / 64) * NB_D;
        constexpr int NITEMS = I_IN + I_OUT + 2 * I_G + I_DN;
        for (int it = gw; it < NITEMS; it += NGW) {
            int r = it;
            if (r < I_IN) { const int kb = r / NB_IN, nb = r % NB_IN; p0_transpose_item(w_in, D, NIN, Win_t, 64 * kb, 32 * nb, 32 * nb, scr, F.lane); continue; } r -= I_IN;
            if (r < I_OUT) { const int kb = r / NB_D, nb = r % NB_D; p0_transpose_item(w_out, D, D, Wout_t, 64 * kb, 32 * nb, 32 * nb, scr, F.lane); continue; } r -= I_OUT;
            if (r < I_G) { const int kb = r / NB_FF, nb = r % NB_FF, n0 = 32 * nb; p0_transpose_item(w_gate, D, FF, Wgu_t, 64 * kb, n0, 256 * (n0 >> 7) + (n0 & 127), scr, F.lane); continue; } r -= I_G;
            if (r < I_G) { const int kb = r / NB_FF, nb = r % NB_FF, n0 = 32 * nb; p0_transpose_item(w_up, D, FF, Wgu_t, 64 * kb, n0, 256 * (n0 >> 7) + 128 + (n0 & 127), scr, F.lane); continue; } r -= I_G;
            { const int kb = r / NB_D, nb = r % NB_D; p0_transpose_item(w_down, FF, D, Wdn_t, 64 * kb, 32 * nb, 32 * nb, scr, F.lane); }
        }
        for (int i = blockIdx.x * 512 + F.tid; i < 4 * 128 * 128; i += F.G * 512) { const int t = (i >> 7) & 127, s = i & 127; Wsp[i] = (bf16)f2bf(s <= t ? sp_w[i] : 0.f); }
        for (int m = gw; m < M; m += NGW) rms_row_to_bf16(F.lane, x + (size_t)m * D, g_mix_pre, XN + (size_t)m * D);
        if (IN(1)) GRID_BAR();
    }
    if (IN(1)) {
        pg8::Gemm g{XN, Win_t, M, NIN, D}; pg8::StaticOrder S; S.init(M, NIN, F.G, (int)blockIdx.x);
        pg8::EpiProj E{PROJ, NIN, mixer::C2};
        pg8::gemm_phase<pg8::EpiProj, pg8::StaticOrder, PG8_ALIGN, PG8_SP2>(F.lds + RING_OFF, g, S, E);
        if (IN(2)) GRID_BAR();
    }
    if (IN(2)) {
        mixer::Tensors MT{PROJ, MIX, LSE, rel_bias, Wsp, ln_g, ln_b, sp_b};
#ifndef NO_GMLP
        for (int i = F.wave * F.G + F.vcu; i < BATCH * 16 * 4; i += NGW) mixer::gmlp_unit(MT, i >> 6, (i >> 2) & 15, i & 3, (LAS char*)(F.lds + RING_OFF) + F.wave * mixer::SLOT, F.lane);
#endif
#ifndef NO_ATTN
        const int NU = BATCH * 12 * 4, per = (NU + F.G - 1) / F.G;
        for (int i = 0; i < per; ++i) { const int U = F.vcu * per + i; if (U >= NU) break;
            mixer::attn_unit(MT, (U >> 2) / 12, (U >> 2) % 12, U & 3, (LAS char*)(F.lds + RING_OFF), (LAS float*)(F.lds + LUT_OFF), F.wave, F.lane); }
#endif
        asm volatile("s_waitcnt vmcnt(0) lgkmcnt(0)" ::: "memory"); __syncthreads();
        if (IN(3)) GRID_BAR();
    }
    if (IN(3)) {
        pg8::Gemm g{MIX, Wout_t, M, D, D}; pg8::StaticOrder S; S.init(M, D, F.G, (int)blockIdx.x);
        pg8::EpiF32 E{Y, D};
        pg8::gemm_phase<pg8::EpiF32, pg8::StaticOrder, PG8_ALIGN, PG8_SP2>(F.lds + RING_OFF, g, S, E);
        if (IN(4)) GRID_BAR();
    }
    if (IN(4)) {
        for (int m = gw; m < M; m += NGW) {
            const GAS f32x4* yr = (const GAS f32x4*)(Y + (size_t)m * D) + F.lane; const GAS f32x4* xr = (const GAS f32x4*)(x + (size_t)m * D) + F.lane;
            const GAS f32x4* g2 = (const GAS f32x4*)g_mix_post + F.lane; const GAS f32x4* g3 = (const GAS f32x4*)g_ffn_pre + F.lane;
            f32x4 v[4]; float s = 0.f;
#pragma unroll
            for (int j = 0; j < 4; ++j) { v[j] = yr[64 * j]; s += (v[j].x * v[j].x + v[j].y * v[j].y) + (v[j].z * v[j].z + v[j].w * v[j].w); }
            const float r = 1.f / sqrtf(wave_sum(s) * (1.f / D) + EPS); float s2 = 0.f;
#pragma unroll
            for (int j = 0; j < 4; ++j) { v[j] = xr[64 * j] + v[j] * r * g2[64 * j]; s2 += (v[j].x * v[j].x + v[j].y * v[j].y) + (v[j].z * v[j].z + v[j].w * v[j].w); }
            const float r2 = 1.f / sqrtf(wave_sum(s2) * (1.f / D) + EPS);
            GAS f32x4* orow = (GAS f32x4*)(out + (size_t)m * D) + F.lane; GAS unsigned long long* o8 = (GAS unsigned long long*)(XN + (size_t)m * D) + F.lane;
#pragma unroll
            for (int j = 0; j < 4; ++j) { orow[64 * j] = v[j]; const f32x4 gg = g3[64 * j];
                o8[64 * j] = (unsigned long long)pk2(v[j].x * r2 * gg.x, v[j].y * r2 * gg.y) | ((unsigned long long)pk2(v[j].z * r2 * gg.z, v[j].w * r2 * gg.w) << 32); }
        }
        if (IN(5)) GRID_BAR();
    }
    if (IN(5)) {
        pg8::Gemm g{XN, Wgu_t, M, NGU, D}; pg8::StaticOrder S; S.init(M, NGU, F.G, (int)blockIdx.x);
        pg8::EpiGateUp E{ACT, FF, conv_w, conv_b, FG, FU, LG};
        pg8::gemm_phase<pg8::EpiGateUp, pg8::StaticOrder, PG8_ALIGN, PG8_SP2>(F.lds + RING_OFF, g, S, E);
        if (IN(6)) GRID_BAR();
    }
    if (IN(6)) {
        constexpr int NG = M / 64, C4 = FF / 4;
        for (int i = blockIdx.x * 512 + F.tid; i < NG * C4; i += F.G * 512) {
            const int grp = i / C4, c = (i % C4) * 4; if ((grp & 31) == 0) continue;
            const f32x4 g0 = *(const f32x4*)(FG + (size_t)(grp * 2) * FF + c), g1 = *(const f32x4*)(FG + (size_t)(grp * 2 + 1) * FF + c);
            const f32x4 u0 = *(const f32x4*)(FU + (size_t)(grp * 2) * FF + c), u1 = *(const f32x4*)(FU + (size_t)(grp * 2 + 1) * FF + c);
            const f32x4 hm2 = *(const f32x4*)(LG + (size_t)(grp * 2 - 2) * FF + c), hm1 = *(const f32x4*)(LG + (size_t)(grp * 2 - 1) * FF + c);
            const f32x4 w0 = *(const f32x4*)(conv_w + c), w1 = *(const f32x4*)(conv_w + FF + c), w2 = *(const f32x4*)(conv_w + 2 * FF + c), bb = *(const f32x4*)(conv_b + c);
            float a0[4], a1[4];
#pragma unroll
            for (int j = 0; j < 4; ++j) { a0[j] = pg8::gelu_tanh(bb[j] + w2[j] * g0[j] + w1[j] * hm1[j] + w0[j] * hm2[j]) * u0[j]; a1[j] = pg8::gelu_tanh(bb[j] + w2[j] * g1[j] + w1[j] * g0[j] + w0[j] * hm1[j]) * u1[j]; }
            *(unsigned long long*)(ACT + (size_t)(grp * 64) * FF + c) = (unsigned long long)pk2(a0[0], a0[1]) | ((unsigned long long)pk2(a0[2], a0[3]) << 32);
            *(unsigned long long*)(ACT + (size_t)(grp * 64 + 1) * FF + c) = (unsigned long long)pk2(a1[0], a1[1]) | ((unsigned long long)pk2(a1[2], a1[3]) << 32);
        }
        if (IN(7)) GRID_BAR();
    }
    if (IN(7)) {
        pg8::Gemm g{ACT, Wdn_t, M, D, FF}; pg8::StaticOrder S; S.init(M, D, F.G, (int)blockIdx.x);
        pg8::EpiF32 E{Y, D};
        pg8::gemm_phase<pg8::EpiF32, pg8::StaticOrder, PG8_ALIGN, PG8_SP2>(F.lds + RING_OFF, g, S, E);
        if (IN(8)) GRID_BAR();
    }
    if (IN(8)) {
        for (int m = gw; m < M; m += NGW) {
            const GAS f32x4* yr = (const GAS f32x4*)(Y + (size_t)m * D) + F.lane; GAS f32x4* orow = (GAS f32x4*)(out + (size_t)m * D) + F.lane;
            const GAS f32x4* g4 = (const GAS f32x4*)g_ffn_post + F.lane;
            f32x4 v[4]; float s = 0.f;
#pragma unroll
            for (int j = 0; j < 4; ++j) { v[j] = yr[64 * j]; s += (v[j].x * v[j].x + v[j].y * v[j].y) + (v[j].z * v[j].z + v[j].w * v[j].w); }
            const float r = 1.f / sqrtf(wave_sum(s) * (1.f / D) + EPS);
#pragma unroll
            for (int j = 0; j < 4; ++j) orow[64 * j] = orow[64 * j] + v[j] * r * g4[64 * j];
        }
    }
#undef IN
#undef GRID_BAR
}

extern "C" void kernel_launch(void* const* d_in, const int* in_sizes, int n_in, void* d_out, int out_size, void* d_ws, size_t ws_size, hipStream_t stream) {
    static int grid = 0;
    if (grid == 0) {
        if (n_in != 17 || in_sizes[0] != M * D || out_size != M * D || ws_size < WS_END) { fprintf(stderr, "kernel_launch: unexpected shapes: n_in %d in0 %d out %d ws %zu (need %zu)\n", n_in, n_in > 0 ? in_sizes[0] : -1, out_size, ws_size, (size_t)WS_END); grid = -1; return; }
        int dev = 0, cus = 0, per_cu = 0;
        if (hipGetDevice(&dev) != hipSuccess || hipDeviceGetAttribute(&cus, hipDeviceAttributeMultiprocessorCount, dev) != hipSuccess) { grid = -1; return; }
        if (hipFuncSetAttribute((const void*)mk_fwd, hipFuncAttributeMaxDynamicSharedMemorySize, LDS_BYTES) != hipSuccess) { fprintf(stderr, "kernel_launch: hipFuncSetAttribute failed\n"); grid = -1; return; }
        if (hipOccupancyMaxActiveBlocksPerMultiprocessor(&per_cu, (const void*)mk_fwd, NWAVES * 64, LDS_BYTES) != hipSuccess || per_cu < 1) fprintf(stderr, "kernel_launch: note: occupancy query reports %d workgroups per CU\n", per_cu);
        (void)hipGetLastError();
        grid = cus;
    }
    if (grid < 0) return;
    if (hipMemsetAsync((char*)d_ws + WS_CTL, 0, CTL_ZERO_BYTES, stream) != hipSuccess) { fprintf(stderr, "kernel_launch: hipMemsetAsync failed\n"); return; }
    Args a{};
    for (int i = 0; i < 17; ++i) a.in[i] = (const float*)d_in[i];
    a.out = (float*)d_out; a.ws = (unsigned char*)d_ws;
    for (int li = 0; li < N_LAUNCHES; ++li) {
        a.ph_lo = (N_LAUNCHES == 1) ? 0 : li; a.ph_hi = (N_LAUNCHES == 1) ? N_PHASES : li + 1; a.li = li;
        hipLaunchKernelGGL(mk_fwd, dim3(grid), dim3(NWAVES * 64), LDS_BYTES, stream, a);
        const hipError_t le = hipPeekAtLastError();
        if (le != hipSuccess) { fprintf(stderr, "kernel_launch: launch %d failed: %s\n", li, hipGetErrorName(le)); break; }
    }
}
```

```cpp
#include <hip/hip_runtime.h>
#include <cstdio>
#include <cstdint>
#include <cmath>
namespace pg8 {
#define PG8_LAS __attribute__((address_space(3)))
typedef unsigned short bf16_t;
typedef short bf16x8 __attribute__((ext_vector_type(8)));
typedef float f32x4 __attribute__((ext_vector_type(4)));
typedef unsigned u32x4 __attribute__((ext_vector_type(4)));
constexpr int BM = 256, BK = 64, HALF = 128, HTB = HALF * BK * 2  , STAGE_BYTES = 8 * HTB, NXCD = 8, WGM = 8;

__host__ __device__ __forceinline__ int lds_byte(int r, int c) { const int st = (r >> 4) * 2 + (c >> 5), rr = r & 15, cc = c & 31, ob = rr * 64 + cc * 2; return st * 1024 + (ob ^ (((ob >> 9) & 1) << 5)); }
__host__ __device__ __forceinline__ void stage_rc(int b, int& R, int& C) { const int st = b / 1024, sb = b % 1024, swz = sb ^ (((sb >> 9) & 1) << 5); R = (st >> 1) * 16 + swz / 64; C = (st & 1) * 32 + (swz % 64) / 2; }
__host__ __device__ __forceinline__ int perm32(int rho) { const int n = rho >> 4, i = rho & 15; return 8 * (i >> 2) + 4 * n + (i & 3); }

struct Unit { int pm, pn; };
struct Gemm { const bf16_t* A; const bf16_t* Bt; int M, N, K; };

struct StaticOrder {
    int nM, nN, nwg, G, c;
    __host__ __device__ void init(int M, int N, int G_, int c_) { nM = M / BM; nN = N / BM; nwg = nM * nN; G = G_; c = c_; }
    __host__ __device__ bool next(int i, Unit& u) const {
        const long L = (long)i * G + c; if (L >= nwg) return false;
        int wgid = (int)L; { const int q = nwg / NXCD, r = nwg % NXCD, xcd = wgid % NXCD, off = wgid / NXCD; wgid = (xcd < r ? xcd * (q + 1) : r * (q + 1) + (xcd - r) * q) + off; }
        const int nig = WGM * nN, gid = wgid / nig, fm = gid * WGM, gsz = (nM - fm) < WGM ? (nM - fm) : WGM;
        u.pm = fm + ((wgid % nig) % gsz); u.pn = (wgid % nig) / gsz; return true;
    }
    __device__ __forceinline__ void a_ready(const Unit&) const {}
    __device__ __forceinline__ void done(const Unit&) const {}
};

__device__ __forceinline__ unsigned cvt_pk_bf16(float lo, float hi) { unsigned r; asm volatile("v_cvt_pk_bf16_f32 %0, %1, %2" : "=v"(r) : "v"(lo), "v"(hi)); return r; }
typedef float f32x2 __attribute__((ext_vector_type(2)));
__device__ __forceinline__ f32x2 gelu_pk(f32x2 v) {
    const f32x2 av = __builtin_elementwise_abs(v), d = av * 0.2316418882f + 1.0f;
    f32x2 t; t.x = __builtin_amdgcn_rcpf(d.x); t.y = __builtin_amdgcn_rcpf(d.y);
    f32x2 q = t * 0.5307027145f + (-0.7265760135f); q = q * t + 0.7107068705f; q = q * t + (-0.142248368f); q = q * t + 0.127414796f; q = q * t;
    const f32x2 s = (v * v) * (-0.72134752044f);
    f32x2 e; e.x = __builtin_amdgcn_exp2f(s.x); e.y = __builtin_amdgcn_exp2f(s.y);
    const f32x2 m = v * (q * e), r = v - m;
    f32x2 o; o.x = v.x < 0.f ? m.x : r.x; o.y = v.y < 0.f ? m.y : r.y; return o;
}

template <int ACT  > struct EpiBf16 {
    static constexpr bool PERM = true, AFTER_DRAIN = false; static_assert(ACT == 0 || ACT == 1, "EpiBf16: ACT is 0 (none) or 1 (gelu_pk)");
    bf16_t* O; int ldc; const float* bias; int split_cols; size_t split_stride; float scale0;
    __device__ __forceinline__ void operator()(const f32x4 (&acc)[2][2][4][2], const Unit& u, int wr, int wc, int fr, int fq) const {
        const int row0 = u.pm * BM + wr * 64 + fr; int colt = u.pn * BM; bf16_t* base = O;
        float sc = 1.f; if (split_cols) { const int t = colt / split_cols; base += (size_t)t * split_stride; colt -= t * split_cols; if (t == 0) sc = scale0; }
        const int col0 = colt + wc * 32 + 8 * fq, bcol0 = u.pn * BM + wc * 32 + 8 * fq;
        f32x4 bv[2][2];
#pragma unroll
        for (int bj = 0; bj < 2; ++bj)
#pragma unroll
            for (int n = 0; n < 2; ++n) bv[bj][n] = bias ? *(const f32x4*)(bias + bcol0 + bj * HALF + 4 * n) : (f32x4){0.f, 0.f, 0.f, 0.f};
#pragma unroll
        for (int ai = 0; ai < 2; ++ai)
#pragma unroll
            for (int m = 0; m < 4; ++m) { bf16_t* rowp = base + (size_t)(row0 + ai * HALF + m * 16) * ldc + col0;
#pragma unroll
                for (int bj = 0; bj < 2; ++bj) { f32x4 v0 = acc[ai][bj][m][0] + bv[bj][0], v1 = acc[ai][bj][m][1] + bv[bj][1];
                    if (ACT == 1) { f32x2 a = gelu_pk((f32x2){v0[0], v0[1]}), b = gelu_pk((f32x2){v0[2], v0[3]}), c = gelu_pk((f32x2){v1[0], v1[1]}), d = gelu_pk((f32x2){v1[2], v1[3]});
                        v0 = (f32x4){a.x, a.y, b.x, b.y}; v1 = (f32x4){c.x, c.y, d.x, d.y}; }
                    v0 = v0 * sc; v1 = v1 * sc; u32x4 w; w.x = cvt_pk_bf16(v0[0], v0[1]); w.y = cvt_pk_bf16(v0[2], v0[3]); w.z = cvt_pk_bf16(v1[0], v1[1]); w.w = cvt_pk_bf16(v1[2], v1[3]);
                    *(u32x4*)(rowp + bj * HALF) = w; } }
    }
};

struct PanelStats {
    unsigned* xbuf;
    unsigned* cnt;
    unsigned* tmo;
    int ntn; float eps;
    unsigned code;
    __device__ __forceinline__ bool run(const f32x4 (&v)[2][2][4][2], const Unit& u, int wr, int wc, int fr, int fq, PG8_LAS unsigned char* lds, int wid, int lane) const {
        typedef float f32x2v __attribute__((ext_vector_type(2)));
        PG8_LAS f32x2v* P = (PG8_LAS f32x2v*)lds;
        PG8_LAS f32x2v* S = (PG8_LAS f32x2v*)(lds + 8192);
        PG8_LAS unsigned* flag = (PG8_LAS unsigned*)(lds + 8192 + 2048);
#pragma unroll
        for (int ai = 0; ai < 2; ++ai)
#pragma unroll
            for (int m = 0; m < 4; ++m) {
                float s = 0.f;
#pragma unroll
                for (int bj = 0; bj < 2; ++bj)
#pragma unroll
                    for (int n = 0; n < 2; ++n) { const f32x4 x = v[ai][bj][m][n]; s += (x[0] + x[1]) + (x[2] + x[3]); }
                s += __shfl_xor(s, 16); s += __shfl_xor(s, 32);
                const float mw = s * (1.0f / 64.0f); float q = 0.f;
#pragma unroll
                for (int bj = 0; bj < 2; ++bj)
#pragma unroll
                    for (int n = 0; n < 2; ++n) { const f32x4 d = v[ai][bj][m][n] - mw; q += (d[0] * d[0] + d[1] * d[1]) + (d[2] * d[2] + d[3] * d[3]); }
                q += __shfl_xor(q, 16); q += __shfl_xor(q, 32);
                if (fq == 0) P[(ai * HALF + wr * 64 + m * 16 + fr) * 4 + wc] = (f32x2v){mw, q};
            }
        asm volatile("s_waitcnt lgkmcnt(0)" ::: "memory"); __builtin_amdgcn_s_barrier(); asm volatile("" ::: "memory");
#if defined(BROKEN_EXCHANGE_NO_WAIT)
#warning BROKEN CONTROL BUILD: the row-statistics exchange does not wait; results are wrong by design
        if (blockIdx.x >= 64) { const long long t0_ = clock64(); while (clock64() - t0_ < 60000) __builtin_amdgcn_s_sleep(8); }
#endif
        const int row = wid * 32 + (lane & 31);
        if (lane < 32) {
            const f32x2v a = P[row * 4 + 0], b = P[row * 4 + 1], c = P[row * 4 + 2], d = P[row * 4 + 3];
            const float mt = (a.x + b.x + c.x + d.x) * 0.25f;
            const float da = a.x - mt, db = b.x - mt, dc = c.x - mt, dd = d.x - mt;
            const float m2 = (a.y + b.y) + (c.y + d.y) + 64.0f * ((da * da + db * db) + (dc * dc + dd * dd));
            unsigned long long* slot = (unsigned long long*)xbuf + ((size_t)(u.pm * BM + row) * 4 + u.pn);
            __hip_atomic_store(slot, ((unsigned long long)__float_as_uint(m2) << 32) | __float_as_uint(mt), __ATOMIC_RELAXED, __HIP_MEMORY_SCOPE_AGENT);
        }
        asm volatile("s_waitcnt vmcnt(0)" ::: "memory");
        if (lane == 0) __hip_atomic_fetch_add(cnt + 64 * u.pm, 1u, __ATOMIC_RELAXED, __HIP_MEMORY_SCOPE_AGENT);
        if (wid == 0) {
            bool dead = false; const unsigned long long t0 = __builtin_amdgcn_s_memrealtime(); const unsigned want = 8u * (unsigned)ntn;
            for (;;) {
#if defined(BROKEN_EXCHANGE_NO_WAIT)
                break;
#endif
                if ((unsigned)__builtin_amdgcn_readfirstlane(__hip_atomic_load(cnt + 64 * u.pm, __ATOMIC_RELAXED, __HIP_MEMORY_SCOPE_AGENT)) >= want) break;
                if (__builtin_amdgcn_s_memrealtime() - t0 > 2000000ull) {
                    if (lane == 0) { unsigned expect = 0u; __hip_atomic_compare_exchange_strong(tmo + 1, &expect, code | (unsigned)(u.pm & 0xff), __ATOMIC_RELAXED, __ATOMIC_RELAXED, __HIP_MEMORY_SCOPE_AGENT);
                                     __hip_atomic_store(tmo, 1u, __ATOMIC_RELAXED, __HIP_MEMORY_SCOPE_AGENT); }
                    dead = true; break; }
                __builtin_amdgcn_s_sleep(2);
            }
            __builtin_amdgcn_fence(__ATOMIC_ACQUIRE, "agent");
            if (lane == 0) flag[0] = dead ? 1u : 0u;
        }
        asm volatile("s_waitcnt vmcnt(0) lgkmcnt(0)" ::: "memory"); __builtin_amdgcn_s_barrier(); asm volatile("" ::: "memory");
        const bool bad = flag[0] != 0u;
        if (lane < 32) {
            const unsigned long long* slot = (const unsigned long long*)xbuf + (size_t)(u.pm * BM + row) * 4; float mt[4], m2[4]; float ms = 0.f;
#pragma unroll
            for (int t = 0; t < 4; ++t) { if (t < ntn) { const unsigned long long w = __hip_atomic_load(slot + t, __ATOMIC_RELAXED, __HIP_MEMORY_SCOPE_AGENT); mt[t] = __uint_as_float((unsigned)w); m2[t] = __uint_as_float((unsigned)(w >> 32)); } else { mt[t] = 0.f; m2[t] = 0.f; } ms += mt[t]; }
            const float mean = ms / (float)ntn; float q = 0.f;
#pragma unroll
            for (int t = 0; t < 4; ++t) if (t < ntn) { const float dm = mt[t] - mean; q += m2[t] + 256.0f * dm * dm; }
            S[row] = (f32x2v){mean, 1.0f / sqrtf(q / (256.0f * (float)ntn) + eps)};
        }
        asm volatile("s_waitcnt lgkmcnt(0)" ::: "memory"); __builtin_amdgcn_s_barrier(); asm volatile("" ::: "memory");
        return bad;
    }
};
struct EpiLnRes {
    static constexpr bool PERM = false, AFTER_DRAIN = true;
    const float* base; float* out; int ldc; const float* bias; PanelStats st; unsigned poison;
    __device__ __forceinline__ void fused(f32x4 (&acc)[2][2][4][2], const Unit& u, int wr, int wc, int fr, int fq, PG8_LAS unsigned char* lds, int wid, int lane) const {
        typedef float f32x2v __attribute__((ext_vector_type(2)));
        const PG8_LAS f32x2v* S = (const PG8_LAS f32x2v*)(lds + 8192);
        const int col0 = u.pn * BM + wc * 32 + 4 * fq;
#pragma unroll
        for (int bj = 0; bj < 2; ++bj)
#pragma unroll
            for (int n = 0; n < 2; ++n) { const f32x4 bv = bias ? *(const f32x4*)(bias + col0 + bj * HALF + n * 16) : (f32x4){0.f, 0.f, 0.f, 0.f};
#pragma unroll
                for (int ai = 0; ai < 2; ++ai)
#pragma unroll
                    for (int m = 0; m < 4; ++m) acc[ai][bj][m][n] += bv; }
        f32x4 pre[4][2][2];
#pragma unroll
        for (int m = 0; m < 4; ++m) { const size_t off = (size_t)(u.pm * BM + wr * 64 + m * 16 + fr) * ldc + col0;
#pragma unroll
            for (int bj = 0; bj < 2; ++bj)
#pragma unroll
                for (int n = 0; n < 2; ++n) pre[m][bj][n] = *(const f32x4*)(base + off + bj * HALF + n * 16); }
        const bool bad = st.run(acc, u, wr, wc, fr, fq, lds, wid, lane) || poison != 0u;
        const float qnan = __builtin_nanf("");
#pragma unroll
        for (int ai = 0; ai < 2; ++ai)
#pragma unroll
            for (int m = 0; m < 4; ++m) { const int r = ai * HALF + wr * 64 + m * 16 + fr; const f32x2v sr = S[r]; const size_t off = (size_t)(u.pm * BM + r) * ldc + col0;
#pragma unroll
                for (int bj = 0; bj < 2; ++bj)
#pragma unroll
                    for (int n = 0; n < 2; ++n) { const f32x4 bs = ai == 0 ? pre[m][bj][n] : *(const f32x4*)(base + off + bj * HALF + n * 16); f32x4 o = bs + (acc[ai][bj][m][n] - sr.x) * sr.y;
                        if (bad) o = (f32x4){qnan, qnan, qnan, qnan}; *(f32x4*)(out + off + bj * HALF + n * 16) = o; }
                if (m & 1) asm volatile("" ::: "memory"); }
    }
};
struct EpiLnResLn {
    static constexpr bool PERM = false, AFTER_DRAIN = true;
    const float* base; float* out; bf16_t* xn; int ldc; const float* bias; PanelStats st1, st2; unsigned poison;
    __device__ __forceinline__ void fused(f32x4 (&acc)[2][2][4][2], const Unit& u, int wr, int wc, int fr, int fq, PG8_LAS unsigned char* lds, int wid, int lane) const {
        typedef float f32x2v __attribute__((ext_vector_type(2))); typedef unsigned u32x2v __attribute__((ext_vector_type(2)));
        const PG8_LAS f32x2v* S = (const PG8_LAS f32x2v*)(lds + 8192);
        const int col0 = u.pn * BM + wc * 32 + 4 * fq;
#pragma unroll
        for (int bj = 0; bj < 2; ++bj)
#pragma unroll
            for (int n = 0; n < 2; ++n) { const f32x4 bv = bias ? *(const f32x4*)(bias + col0 + bj * HALF + n * 16) : (f32x4){0.f, 0.f, 0.f, 0.f};
#pragma unroll
                for (int ai = 0; ai < 2; ++ai)
#pragma unroll
                    for (int m = 0; m < 4; ++m) acc[ai][bj][m][n] += bv; }
        bool bad = st1.run(acc, u, wr, wc, fr, fq, lds, wid, lane) || poison != 0u;
        const float qnan = __builtin_nanf("");
#pragma unroll
        for (int ai = 0; ai < 2; ++ai)
#pragma unroll
            for (int m = 0; m < 4; ++m) { const int r = ai * HALF + wr * 64 + m * 16 + fr; const f32x2v sr = S[r]; const size_t off = (size_t)(u.pm * BM + r) * ldc + col0;
#pragma unroll
                for (int bj = 0; bj < 2; ++bj)
#pragma unroll
                    for (int n = 0; n < 2; ++n) { const f32x4 bs = *(const f32x4*)(base + off + bj * HALF + n * 16); acc[ai][bj][m][n] = bs + (acc[ai][bj][m][n] - sr.x) * sr.y; }
                asm volatile("" : "+v"(acc[ai][0][m][0]), "+v"(acc[ai][0][m][1]), "+v"(acc[ai][1][m][0]), "+v"(acc[ai][1][m][1]));
                if (m & 1) asm volatile("" ::: "memory"); }
        const bool bad1 = bad;
        bad = st2.run(acc, u, wr, wc, fr, fq, lds, wid, lane) || bad;
#pragma unroll
        for (int ai = 0; ai < 2; ++ai)
#pragma unroll
            for (int m = 0; m < 4; ++m) { const int r = ai * HALF + wr * 64 + m * 16 + fr; const f32x2v sr = S[r]; const size_t off = (size_t)(u.pm * BM + r) * ldc + col0;
#pragma unroll
                for (int bj = 0; bj < 2; ++bj)
#pragma unroll
                    for (int n = 0; n < 2; ++n) { const f32x4 x1 = acc[ai][bj][m][n]; *(f32x4*)(out + off + bj * HALF + n * 16) = bad1 ? (f32x4){qnan, qnan, qnan, qnan} : x1;
                        const f32x4 o = (x1 - sr.x) * sr.y; u32x2v w; w.x = cvt_pk_bf16(o[0], o[1]); w.y = cvt_pk_bf16(o[2], o[3]);
                        if (bad) { w.x = 0x7fc07fc0u; w.y = 0x7fc07fc0u; } *(u32x2v*)(xn + off + bj * HALF + n * 16) = w; }
                asm volatile("" ::: "memory"); }
    }
};

template <class Epi, class Sched, bool ALIGN_EPI = false, bool SP2 = false>
__device__ __forceinline__ void gemm_phase(PG8_LAS unsigned char* lds, const Gemm g, const Sched& S, const Epi& E) {
    const int tid = threadIdx.x, wid = __builtin_amdgcn_readfirstlane(tid >> 6), lane = tid & 63, wr = wid >> 2, wc = wid & 3, fr = lane & 15, fq = lane >> 4;
    const int K = g.K, nt = K / BK;
    unsigned voffA[2], voffB[2];
#pragma unroll
    for (int i = 0; i < 2; ++i) { int R, C; stage_rc(tid * 16 + i * 8192, R, C); const int Rb = Epi::PERM ? ((R & ~31) + perm32(R & 31)) : R;
        voffA[i] = (unsigned)(R * K + C) * 2u; voffB[i] = (unsigned)(Rb * K + C) * 2u; }
    const size_t kstep = (size_t)(BK * 2);
    const size_t hstep = (size_t)HALF * K * 2;
    const size_t tstep = 2 * hstep;
    const unsigned ldsw = (unsigned)wid * 1024u;
    const int aoff = lds_byte(wr * 64 + fr, fq * 8), boff = lds_byte(wc * 32 + fr, fq * 8);
#define PG8_SA(b, h) (((b) * 2 + (h)) * HTB)
#define PG8_SB(b, h) ((4 + (b) * 2 + (h)) * HTB)
#define PG8_STAGE(bufoff, gbase, voff) do { _Pragma("unroll") for (int _i = 0; _i < 2; ++_i) \
        __builtin_amdgcn_global_load_lds((const unsigned*)((const char*)(gbase) + (voff)[_i]), (PG8_LAS unsigned*)(lds + (bufoff) + ldsw + _i * 8192), 16, 0, 0); } while (0)
#define PG8_LDA(dst, b, h) do { _Pragma("unroll") for (int m = 0; m < 4; ++m) _Pragma("unroll") for (int k = 0; k < 2; ++k) dst[m][k] = *(const PG8_LAS bf16x8*)(lds + PG8_SA(b, h) + aoff + m * 2048 + k * 1024); } while (0)
#define PG8_LDB(dst, b, h) do { _Pragma("unroll") for (int n = 0; n < 2; ++n) _Pragma("unroll") for (int k = 0; k < 2; ++k) dst[n][k] = *(const PG8_LAS bf16x8*)(lds + PG8_SB(b, h) + boff + n * 2048 + k * 1024); } while (0)
#define PG8_MMA(ai, bj, At, Bt) do { __builtin_amdgcn_s_setprio(1); _Pragma("unroll") for (int m = 0; m < 4; ++m) _Pragma("unroll") for (int n = 0; n < 2; ++n) _Pragma("unroll") for (int k = 0; k < 2; ++k) \
        acc[ai][bj][m][n] = __builtin_amdgcn_mfma_f32_16x16x32_bf16(Bt[n][k], At[m][k], acc[ai][bj][m][n], 0, 0, 0); __builtin_amdgcn_s_setprio(0); } while (0)
#define PG8_WAIT_V(n) asm volatile("s_waitcnt vmcnt(" #n ")" ::: "memory")
#define PG8_WAIT_L(n) asm volatile("s_waitcnt lgkmcnt(" #n ")" ::: "memory")
#define PG8_BAR __builtin_amdgcn_s_barrier()
#define PG8_SCHED __builtin_amdgcn_sched_barrier(0)
    Unit cur, nxt; int ui = 0;
    if (!S.next(0, cur)) return;
    f32x4 acc[2][2][4][2];
#pragma unroll
    for (int a = 0; a < 2; ++a)
#pragma unroll
        for (int b = 0; b < 2; ++b)
#pragma unroll
            for (int m = 0; m < 4; ++m)
#pragma unroll
                for (int n = 0; n < 2; ++n) acc[a][b][m][n] = (f32x4){0.f, 0.f, 0.f, 0.f};
    bf16x8 At[4][2], B0[2][2], B1[2][2];
    const char* cA = (const char*)g.A + (size_t)cur.pm * tstep; const char* cB = (const char*)g.Bt + (size_t)cur.pn * tstep;
    S.a_ready(cur);
    if constexpr (SP2) {
        PG8_STAGE(PG8_SB(0, 0), cB, voffB); PG8_STAGE(PG8_SB(0, 1), cB + hstep, voffB); PG8_STAGE(PG8_SA(0, 0), cA, voffA); PG8_STAGE(PG8_SA(0, 1), cA + hstep, voffA);
        if (wr == 1) PG8_BAR;
        PG8_WAIT_V(2); PG8_BAR;
        PG8_STAGE(PG8_SB(1, 0), cB + kstep, voffB); PG8_STAGE(PG8_SA(1, 0), cA + kstep, voffA); PG8_STAGE(PG8_SB(1, 1), cB + hstep + kstep, voffB);
        PG8_WAIT_V(6); PG8_BAR;
    } else {
        PG8_STAGE(PG8_SB(0, 0), cB, voffB); PG8_STAGE(PG8_SA(0, 0), cA, voffA); PG8_STAGE(PG8_SB(0, 1), cB + hstep, voffB); PG8_STAGE(PG8_SA(0, 1), cA + hstep, voffA);
        if (wr == 1) PG8_BAR;
        PG8_WAIT_V(4); PG8_BAR;
        PG8_STAGE(PG8_SB(1, 0), cB + kstep, voffB); PG8_STAGE(PG8_SA(1, 0), cA + kstep, voffA); PG8_STAGE(PG8_SB(1, 1), cB + hstep + kstep, voffB);
        PG8_WAIT_V(6); PG8_BAR;
    }
    for (;;) {
        const bool has_next = S.next(ui + 1, nxt);
        const char* nA = has_next ? (const char*)g.A + (size_t)nxt.pm * tstep : cA; const char* nB = has_next ? (const char*)g.Bt + (size_t)nxt.pn * tstep : cB;
        for (int t = 0; t < nt; t += 2) {
            const bool last = (t == nt - 2);
            const char* a1 = cA + (size_t)(t + 1) * kstep;
            const char* a2 = last ? nA : cA + (size_t)(t + 2) * kstep; const char* b2 = last ? nB : cB + (size_t)(t + 2) * kstep;
            const char* a3 = a2 + kstep; const char* b3 = b2 + kstep;
            if (last && has_next) S.a_ready(nxt);
            if constexpr (SP2) {
            PG8_LDB(B0, 0, 0); PG8_LDB(B1, 0, 1); PG8_SCHED; PG8_LDA(At, 0, 0); PG8_STAGE(PG8_SA(1, 1), a1 + hstep, voffA);
            PG8_WAIT_V(8); PG8_WAIT_L(0); PG8_BAR; PG8_MMA(0, 0, At, B0); PG8_MMA(0, 1, At, B1); PG8_BAR; PG8_SCHED;
            PG8_LDA(At, 0, 1); PG8_STAGE(PG8_SB(0, 0), b2, voffB); PG8_STAGE(PG8_SB(0, 1), b2 + hstep, voffB); PG8_STAGE(PG8_SA(0, 0), a2, voffA);
            PG8_WAIT_V(8); PG8_WAIT_L(0); PG8_BAR; PG8_MMA(1, 0, At, B0); PG8_MMA(1, 1, At, B1); PG8_BAR; PG8_SCHED;
            PG8_LDB(B0, 1, 0); PG8_LDB(B1, 1, 1); PG8_SCHED; PG8_LDA(At, 1, 0); PG8_STAGE(PG8_SA(0, 1), a2 + hstep, voffA);
            PG8_WAIT_V(8); PG8_WAIT_L(0); PG8_BAR; PG8_MMA(0, 0, At, B0); PG8_MMA(0, 1, At, B1); PG8_BAR; PG8_SCHED;
            PG8_LDA(At, 1, 1); PG8_STAGE(PG8_SB(1, 0), b3, voffB); PG8_STAGE(PG8_SB(1, 1), b3 + hstep, voffB); PG8_STAGE(PG8_SA(1, 0), a3, voffA);
            PG8_WAIT_V(8); PG8_WAIT_L(0); PG8_BAR; PG8_MMA(1, 0, At, B0); PG8_MMA(1, 1, At, B1); PG8_BAR; PG8_SCHED;
            } else {
            PG8_LDB(B0, 0, 0); PG8_SCHED; PG8_LDA(At, 0, 0); PG8_STAGE(PG8_SA(1, 1), a1 + hstep, voffA);
            PG8_WAIT_L(8); PG8_BAR; PG8_WAIT_L(0); PG8_MMA(0, 0, At, B0); PG8_BAR; PG8_SCHED;
            PG8_LDB(B1, 0, 1); PG8_STAGE(PG8_SB(0, 0), b2, voffB);
            PG8_BAR; PG8_WAIT_L(0); PG8_MMA(0, 1, At, B1); PG8_BAR;
            PG8_LDA(At, 0, 1); PG8_STAGE(PG8_SA(0, 0), a2, voffA);
            PG8_BAR; PG8_WAIT_L(0); PG8_MMA(1, 0, At, B0); PG8_BAR; PG8_SCHED;
            PG8_STAGE(PG8_SB(0, 1), b2 + hstep, voffB);
            PG8_WAIT_V(6); PG8_BAR; PG8_MMA(1, 1, At, B1); PG8_BAR;
            PG8_LDB(B0, 1, 0); PG8_SCHED; PG8_LDA(At, 1, 0); PG8_STAGE(PG8_SA(0, 1), a2 + hstep, voffA);
            PG8_WAIT_L(8); PG8_BAR; PG8_WAIT_L(0); PG8_MMA(0, 0, At, B0); PG8_BAR; PG8_SCHED;
            PG8_LDB(B1, 1, 1); PG8_STAGE(PG8_SB(1, 0), b3, voffB);
            PG8_BAR; PG8_WAIT_L(0); PG8_MMA(0, 1, At, B1); PG8_BAR;
            PG8_LDA(At, 1, 1); PG8_STAGE(PG8_SA(1, 0), a3, voffA);
            PG8_BAR; PG8_WAIT_L(0); PG8_MMA(1, 0, At, B0); PG8_BAR; PG8_SCHED;
            PG8_STAGE(PG8_SB(1, 1), b3 + hstep, voffB);
            PG8_WAIT_V(6); PG8_BAR; PG8_MMA(1, 1, At, B1); PG8_BAR;
            }
        }
        if constexpr (ALIGN_EPI) { if (wr == 0) PG8_BAR; }
        if constexpr (!Epi::AFTER_DRAIN) { E(acc, cur, wr, wc, fr, fq); S.done(cur); }
        if (!has_next) break;
#pragma unroll
        for (int a = 0; a < 2; ++a)
#pragma unroll
            for (int b = 0; b < 2; ++b)
#pragma unroll
                for (int m = 0; m < 4; ++m)
#pragma unroll
                    for (int n = 0; n < 2; ++n) acc[a][b][m][n] = (f32x4){0.f, 0.f, 0.f, 0.f};
        cur = nxt; cA = nA; cB = nB; ++ui;
        if constexpr (ALIGN_EPI) { if (wr == 1) PG8_BAR; }
    }
    PG8_WAIT_V(0);
    if constexpr (!ALIGN_EPI) { if (wr == 0) PG8_BAR; }
    PG8_BAR;
    if constexpr (Epi::AFTER_DRAIN) { E.fused(acc, cur, wr, wc, fr, fq, lds, wid, lane); S.done(cur); }
#undef PG8_SA
#undef PG8_SB
#undef PG8_STAGE
#undef PG8_LDA
#undef PG8_LDB
#undef PG8_MMA
#undef PG8_WAIT_V
#undef PG8_WAIT_L
#undef PG8_BAR
#undef PG8_SCHED
}
}
#ifndef PG8_SP2
#define PG8_SP2 true
#endif
#ifndef PG8_ALIGN
#define PG8_ALIGN true
#endif
namespace pg8 {
__device__ __forceinline__ float gelu_tanh(float x) {
    const float GC1 = -2.3022082f, GC2 = -0.10294324f;
    const float e = __builtin_amdgcn_exp2f(x * (GC1 + GC2 * x * x));
    return x * __builtin_amdgcn_rcpf(1.0f + e);
}
struct EpiProj {
    static constexpr bool PERM = true, AFTER_DRAIN = false;
    bf16_t* O; int ldc; float qscale; bf16_t* KV;
    __device__ __forceinline__ void operator()(const f32x4 (&acc)[2][2][4][2], const Unit& u, int wr, int wc, int fr, int fq) const {
        const int row0 = u.pm * BM + wr * 64 + fr, col0 = u.pn * BM + wc * 32 + 8 * fq;
        const float sc = (u.pn >= 2 && u.pn < 5) ? qscale : 1.f;
#pragma unroll
        for (int ai = 0; ai < 2; ++ai)
#pragma unroll
            for (int m = 0; m < 4; ++m) { const int row = row0 + ai * HALF + m * 16;
#pragma unroll
                for (int bj = 0; bj < 2; ++bj) { const f32x4 v0 = acc[ai][bj][m][0] * sc, v1 = acc[ai][bj][m][1] * sc;
                    u32x4 w; w.x = cvt_pk_bf16(v0[0], v0[1]); w.y = cvt_pk_bf16(v0[2], v0[3]); w.z = cvt_pk_bf16(v1[0], v1[1]); w.w = cvt_pk_bf16(v1[2], v1[3]);
                    bf16_t* dst;
                    if (u.pn < 5) dst = O + (size_t)row * ldc + col0 + bj * HALF;
                    else { const int kc = col0 + bj * HALF - 1280, isv = kc >= 768 ? 1 : 0, hc = kc - 768 * isv;
                        dst = KV + ((size_t)((row >> 11) * 12 + (hc >> 6)) * 2048 + (row & 2047)) * 128 + isv * 64 + (hc & 63); }
                    *(u32x4*)dst = w; } }
    }
};
struct EpiF32 {
    static constexpr bool PERM = false, AFTER_DRAIN = false;
    float* out; int ldc;
    __device__ __forceinline__ void operator()(const f32x4 (&acc)[2][2][4][2], const Unit& u, int wr, int wc, int fr, int fq) const {
        const int col0 = u.pn * BM + wc * 32 + 4 * fq;
#pragma unroll
        for (int ai = 0; ai < 2; ++ai)
#pragma unroll
            for (int m = 0; m < 4; ++m) { const int r = ai * HALF + wr * 64 + m * 16 + fr; const size_t off = (size_t)(u.pm * BM + r) * ldc + col0;
#pragma unroll
                for (int bj = 0; bj < 2; ++bj)
#pragma unroll
                    for (int n = 0; n < 2; ++n) *(f32x4*)(out + off + bj * HALF + n * 16) = acc[ai][bj][m][n]; }
    }
};
__device__ __forceinline__ float dpp_ror1(float v) { return __builtin_bit_cast(float, __builtin_amdgcn_update_dpp(0, __builtin_bit_cast(int, v), 0x121, 0xf, 0xf, true)); }
__device__ __forceinline__ float dpp_ror2(float v) { return __builtin_bit_cast(float, __builtin_amdgcn_update_dpp(0, __builtin_bit_cast(int, v), 0x122, 0xf, 0xf, true)); }
__device__ __forceinline__ float dpp_shr1(float old, float v) { return __builtin_bit_cast(float, __builtin_amdgcn_update_dpp(__builtin_bit_cast(int, old), __builtin_bit_cast(int, v), 0x111, 0xf, 0xf, false)); }
__device__ __forceinline__ float dpp_shr2(float old, float v) { return __builtin_bit_cast(float, __builtin_amdgcn_update_dpp(__builtin_bit_cast(int, old), __builtin_bit_cast(int, v), 0x112, 0xf, 0xf, false)); }
struct EpiGateUp {
    static constexpr bool PERM = true, AFTER_DRAIN = false;
    bf16_t* ACT; int ldc; const float* cw; const float* cb; float* FG; float* FU; float* LG;
    __device__ __forceinline__ void operator()(const f32x4 (&acc)[2][2][4][2], const Unit& u, int wr, int wc, int fr, int fq) const {
        const int gc0 = u.pn * 128 + wc * 32 + 8 * fq;
        f32x4 w0[2], w1[2], w2[2], bb[2];
#pragma unroll
        for (int n = 0; n < 2; ++n) { w0[n] = *(const f32x4*)(cw + gc0 + 4 * n); w1[n] = *(const f32x4*)(cw + ldc + gc0 + 4 * n); w2[n] = *(const f32x4*)(cw + 2 * ldc + gc0 + 4 * n); bb[n] = *(const f32x4*)(cb + gc0 + 4 * n); }
#pragma unroll
        for (int ai = 0; ai < 2; ++ai) {
            const int grp = u.pm * 4 + ai * 2 + wr;
            f32x4 prev[2]; prev[0] = (f32x4){0.f, 0.f, 0.f, 0.f}; prev[1] = prev[0];
#pragma unroll
            for (int m = 0; m < 4; ++m) {
                float a[8];
#pragma unroll
                for (int n = 0; n < 2; ++n) { const f32x4 G = acc[ai][0][m][n], U = acc[ai][1][m][n];
#pragma unroll
                    for (int j = 0; j < 4; ++j) { const float p1 = dpp_shr1(dpp_ror1(prev[n][j]), G[j]), p2 = dpp_shr2(dpp_ror2(prev[n][j]), G[j]);
                        const float cv = bb[n][j] + w2[n][j] * G[j] + w1[n][j] * p1 + w0[n][j] * p2; a[4 * n + j] = gelu_tanh(cv) * U[j]; }
                    if (m == 0 && fr < 2) { *(f32x4*)(FG + (size_t)(grp * 2 + fr) * ldc + gc0 + 4 * n) = G; *(f32x4*)(FU + (size_t)(grp * 2 + fr) * ldc + gc0 + 4 * n) = U; }
                    if (m == 3 && fr >= 14) *(f32x4*)(LG + (size_t)(grp * 2 + fr - 14) * ldc + gc0 + 4 * n) = G;
                    prev[n] = G; }
                u32x4 w; w.x = cvt_pk_bf16(a[0], a[1]); w.y = cvt_pk_bf16(a[2], a[3]); w.z = cvt_pk_bf16(a[4], a[5]); w.w = cvt_pk_bf16(a[6], a[7]);
                *(u32x4*)(ACT + (size_t)(u.pm * BM + ai * HALF + wr * 64 + m * 16 + fr) * ldc + gc0) = w;
            }
        }
    }
};
}
namespace mixer {
#define MX_LAS __attribute__((address_space(3)))
using bf16x8 = __attribute__((ext_vector_type(8))) short;
using s16x4 = __attribute__((ext_vector_type(4))) short;
using f32x16 = __attribute__((ext_vector_type(16))) float;
using f32x4 = __attribute__((ext_vector_type(4))) float;
using u32x4 = __attribute__((ext_vector_type(4))) unsigned;
using u32x2 = __attribute__((ext_vector_type(2))) unsigned;
typedef unsigned short bf16_t;
typedef MX_LAS const char* lds_cptr;
typedef short v4i16_t __attribute__((ext_vector_type(4)));
constexpr int SEQ = 2048, NH = 12, PP = 1280, MP = 1024, KP = 128;
constexpr int COL_U = 0, COL_V = 256, COL_Q = 512, MIX_B = 256;
constexpr float LOG2E = 1.4426950408889634f, C2 = 0.125f * LOG2E;
constexpr int SLOT = 16384, KOFF = 0, VOFF = 8192, LUTN = 256;
__device__ __forceinline__ float max3f(float a, float b, float c) { return __builtin_fmaxf(__builtin_fmaxf(a, b), c); }
typedef float f32x2_t __attribute__((ext_vector_type(2))); typedef __bf16 bf16x2_t __attribute__((ext_vector_type(2)));
__device__ __forceinline__ unsigned cvtpk(float lo, float hi) { f32x2_t v = {lo, hi}; bf16x2_t b = __builtin_convertvector(v, bf16x2_t); return __builtin_bit_cast(unsigned, b); }
__device__ __forceinline__ float bf2f(unsigned short h) { return __builtin_bit_cast(float, (unsigned)h << 16); }
__device__ __forceinline__ s16x4 vtr(lds_cptr p) { return __builtin_bit_cast(s16x4, __builtin_amdgcn_ds_read_tr16_b64_v4i16((MX_LAS v4i16_t*)p)); }
__device__ __forceinline__ float gelu_tanh(float x) {
    const float e = __builtin_amdgcn_exp2f(x * (-2.3022082f + -0.10294324f * x * x));
    return x * __builtin_amdgcn_rcpf(1.0f + e);
}
__device__ __forceinline__ void dma_tile(MX_LAS char* slot, const bf16_t* kp, const bf16_t* vp, long vstep) {
#pragma unroll
    for (int c = 0; c < 8; ++c) __builtin_amdgcn_global_load_lds((const unsigned*)(kp + 8 * c), (MX_LAS unsigned*)(slot + KOFF + c * 1024), 16, 0, 0);
#pragma unroll
    for (int dh = 0; dh < 2; ++dh)
#pragma unroll
        for (int g = 0; g < 4; ++g) __builtin_amdgcn_global_load_lds((const unsigned*)(vp + g * vstep + dh * 32), (MX_LAS unsigned*)(slot + VOFF + (dh * 4 + g) * 1024), 16, 0, 0);
}
__device__ __forceinline__ void block_tile(f32x16& o0, f32x16& o1, float& m, float& l, const bf16x8 (&qr)[4], lds_cptr kl, lds_cptr vl, const MX_LAS float* lut) {
    f32x16 s0, s1;
#pragma unroll
    for (int r = 0; r < 16; ++r) { s0[r] = lut[(r & 3) + 8 * (r >> 2)]; s1[r] = lut[32 + (r & 3) + 8 * (r >> 2)]; }
#pragma unroll
    for (int d0 = 0; d0 < 4; ++d0) {
        const bf16x8 b0 = *(const MX_LAS bf16x8*)(kl + d0 * 2048), b1 = *(const MX_LAS bf16x8*)(kl + d0 * 2048 + 512);
        s0 = __builtin_amdgcn_mfma_f32_32x32x16_bf16(b0, qr[d0], s0, 0, 0, 0);
        s1 = __builtin_amdgcn_mfma_f32_32x32x16_bf16(b1, qr[d0], s1, 0, 0, 0);
    }
    float a = max3f(s0[0], s0[1], s1[0]), b = max3f(s0[2], s0[3], s1[1]); a = max3f(a, s1[2], s1[3]);
#pragma unroll
    for (int r = 4; r < 16; r += 4) { a = max3f(a, s0[r], s0[r + 1]); b = max3f(b, s0[r + 2], s0[r + 3]); a = max3f(a, s1[r], s1[r + 1]); b = max3f(b, s1[r + 2], s1[r + 3]); }
    float rm = __builtin_fmaxf(a, b);
    { auto rr = __builtin_amdgcn_permlane32_swap(__float_as_uint(rm), __float_as_uint(rm), false, false); rm = __builtin_fmaxf(__uint_as_float(rr[0]), __uint_as_float(rr[1])); }
    const float mn = __builtin_fmaxf(m, rm), alpha = __builtin_amdgcn_exp2f(m - mn); m = mn;
    float ps = 0.f;
#pragma unroll
    for (int r = 0; r < 16; ++r) { s0[r] = __builtin_amdgcn_exp2f(s0[r] - mn); s1[r] = __builtin_amdgcn_exp2f(s1[r] - mn); ps += s0[r] + s1[r]; }
    l = l * alpha + ps;
#pragma unroll
    for (int r = 0; r < 16; ++r) { o0[r] *= alpha; o1[r] *= alpha; }
    u32x4 pw[4];
#pragma unroll
    for (int i = 0; i < 4; ++i) { pw[0][i] = cvtpk(s0[2 * i], s0[2 * i + 1]); pw[1][i] = cvtpk(s0[8 + 2 * i], s0[8 + 2 * i + 1]); pw[2][i] = cvtpk(s1[2 * i], s1[2 * i + 1]); pw[3][i] = cvtpk(s1[8 + 2 * i], s1[8 + 2 * i + 1]); }
#pragma unroll
    for (int ks = 0; ks < 4; ++ks) {
        const s16x4 lo0 = vtr(vl + ks * 1024), hi0 = vtr(vl + ks * 1024 + 512), lo1 = vtr(vl + 4096 + ks * 1024), hi1 = vtr(vl + 4096 + ks * 1024 + 512);
        const bf16x8 v0 = (bf16x8){lo0[0], lo0[1], lo0[2], lo0[3], hi0[0], hi0[1], hi0[2], hi0[3]}, v1 = (bf16x8){lo1[0], lo1[1], lo1[2], lo1[3], hi1[0], hi1[1], hi1[2], hi1[3]};
        const bf16x8 p = __builtin_bit_cast(bf16x8, pw[ks]);
        o0 = __builtin_amdgcn_mfma_f32_32x32x16_bf16(v0, p, o0, 0, 0, 0);
        o1 = __builtin_amdgcn_mfma_f32_32x32x16_bf16(v1, p, o1, 0, 0, 0);
    }
}
struct Tensors { const bf16_t* PROJ; const bf16_t* KV; bf16_t* MIX; float* LSE; const float* rel_bias; const bf16_t* WSP; const float* ln_g; const float* ln_b; const float* sp_b; };
#define MX_WAIT_V0() asm volatile("s_waitcnt vmcnt(0)" ::: "memory")
#define MX_WAIT_L0() asm volatile("s_waitcnt lgkmcnt(0)" ::: "memory")

__device__ __forceinline__ void attn_unit(const Tensors& T, int b, int h, int n, MX_LAS char* lds, MX_LAS float* LUT, int wave, int lane) {
    const int r32 = lane & 31, hi = lane >> 5, tid = threadIdx.x;
    __syncthreads();
    for (int i = tid; i < 3 * LUTN; i += 512) {
        const int seg = i >> 8, x = i & 255, rel = 192 - x; float v = -INFINITY;
        if (rel >= 0 && rel <= 128) { const int dist = rel << (2 * seg); int bk = dist;
            if (dist >= 16) { bk = 16 + (int)(__log2f((float)dist * 0.0625f) * (16.0f / 7.0f)); bk = bk > 31 ? 31 : bk; }
            v = T.rel_bias[bk * NH + h] * LOG2E; }
        LUT[i] = v;
    }
    __syncthreads();
    MX_LAS char* slot = lds + wave * SLOT;
    const lds_cptr kl = (lds_cptr)slot + KOFF + hi * 1024 + r32 * 16;
    const lds_cptr vl = (lds_cptr)slot + VOFF + ((lane >> 4) & 1) * 32 + (lane & 3) * 8 + (4 * hi + ((lane & 15) >> 2)) * 64;
    const long rowb = (long)b * SEQ; const int P0 = 512 * n;
    const bf16_t* Kh = T.KV + (long)(b * NH + h) * SEQ * KP; const bf16_t* Vh = Kh + 64; const bf16_t* Qh = T.PROJ + rowb * PP + COL_Q + 64 * h;
    bf16_t* Mh = T.MIX + rowb * MP + MIX_B + 64 * h; float* Lh = T.LSE + rowb * NH + h;
    {
        bf16x8 qa[4], qb[4];
        const int pa = P0 + 64 * wave + r32, pb = pa + 32;
#pragma unroll
        for (int d0 = 0; d0 < 4; ++d0) { qa[d0] = *(const bf16x8*)(Qh + (long)pa * PP + d0 * 16 + hi * 8); qb[d0] = *(const bf16x8*)(Qh + (long)pb * PP + d0 * 16 + hi * 8); }
        f32x16 oa0 = {}, oa1 = {}, ob0 = {}, ob1 = {}; float ma = -1e30f, la = 0.f, mb = -1e30f, lb = 0.f;
#pragma unroll 1
        for (int a = 0; a < 3; ++a) {
            const int k0 = P0 + 64 * wave - 128 + 64 * a; if (k0 < 0) continue;
            MX_WAIT_L0();
            dma_tile(slot, Kh + (long)(k0 + lane) * KP, Vh + (long)(k0 + (lane >> 2)) * KP + (lane & 3) * 8, 16L * KP);
            MX_WAIT_V0();
            const int xa = 64 + 64 * a - r32 + 4 * hi, xb = xa - 32;
            block_tile(oa0, oa1, ma, la, qa, kl, vl, LUT + xa);
            __builtin_amdgcn_sched_barrier(0);
            block_tile(ob0, ob1, mb, lb, qb, kl, vl, LUT + xb);
        }
#define MX_EPI_A(o0_, o1_, m_, l_, p_) do { float lt = l_; { auto rr = __builtin_amdgcn_permlane32_swap(__float_as_uint(lt), __float_as_uint(lt), false, false); lt = __uint_as_float(rr[0]) + __uint_as_float(rr[1]); } \
            const float il = __builtin_amdgcn_rcpf(lt); bf16_t* mrow = Mh + (long)(p_) * MP + 4 * hi; \
            _Pragma("unroll") for (int rq = 0; rq < 4; ++rq) { u32x2 w0, w1; w0.x = cvtpk(o0_[4 * rq] * il, o0_[4 * rq + 1] * il); w0.y = cvtpk(o0_[4 * rq + 2] * il, o0_[4 * rq + 3] * il); \
                w1.x = cvtpk(o1_[4 * rq] * il, o1_[4 * rq + 1] * il); w1.y = cvtpk(o1_[4 * rq + 2] * il, o1_[4 * rq + 3] * il); *(u32x2*)(mrow + 8 * rq) = w0; *(u32x2*)(mrow + 32 + 8 * rq) = w1; } \
            if (hi == 0) Lh[(long)(p_) * NH] = m_ + __log2f(lt); } while (0)
        MX_EPI_A(oa0, oa1, ma, la, pa);
        MX_EPI_A(ob0, ob1, mb, lb, pb);
#undef MX_EPI_A
    }
    MX_WAIT_V0(); MX_WAIT_L0();
    __syncthreads();
    {
        const int ra = wave, rb = wave + 8, c4 = wave & 3;
        const int pa = P0 + 16 * r32 + ra, pb = P0 + 16 * r32 + rb;
        bf16x8 qa[4], qb[4];
#pragma unroll
        for (int d0 = 0; d0 < 4; ++d0) { qa[d0] = *(const bf16x8*)(Qh + (long)pa * PP + d0 * 16 + hi * 8); qb[d0] = *(const bf16x8*)(Qh + (long)pb * PP + d0 * 16 + hi * 8); }
        f32x16 oa0 = {}, oa1 = {}, ob0 = {}, ob1 = {}; float ma = -1e30f, la = 0.f, mb = -1e30f, lb = 0.f;
#pragma unroll 1
        for (int a = 0; a < 4; ++a) {
            const int jk0 = 128 * (n - 1) + 64 * a; if (jk0 < 0) continue;
            MX_WAIT_L0();
            dma_tile(slot, Kh + (long)(4 * (jk0 + lane) + c4) * KP, Vh + (long)(4 * (jk0 + (lane >> 2)) + c4) * KP + (lane & 3) * 8, 64L * KP);
            MX_WAIT_V0();
            int xa = 64 + 64 * a - (ra >> 2) - 4 * r32 + 4 * hi, xb = 64 + 64 * a - (rb >> 2) - 4 * r32 + 4 * hi;
            xa = xa < 0 ? 0 : (xa > 196 ? 196 : xa); xb = xb < 0 ? 0 : (xb > 196 ? 196 : xb);
            block_tile(oa0, oa1, ma, la, qa, kl, vl, LUT + LUTN + xa);
            __builtin_amdgcn_sched_barrier(0);
            block_tile(ob0, ob1, mb, lb, qb, kl, vl, LUT + LUTN + xb);
        }
#pragma unroll 1
        for (int a = 0; a <= (n >> 1); ++a) {
            const int x3 = 192 - 32 * n + 64 * a - r32 + 4 * hi;
            MX_WAIT_L0();
            dma_tile(slot, Kh + (long)(16 * (64 * a + lane) + ra) * KP, Vh + (long)(16 * (64 * a + (lane >> 2)) + ra) * KP + (lane & 3) * 8, 256L * KP);
            MX_WAIT_V0();
            block_tile(oa0, oa1, ma, la, qa, kl, vl, LUT + 2 * LUTN + x3);
            MX_WAIT_L0();
            dma_tile(slot, Kh + (long)(16 * (64 * a + lane) + rb) * KP, Vh + (long)(16 * (64 * a + (lane >> 2)) + rb) * KP + (lane & 3) * 8, 256L * KP);
            MX_WAIT_V0();
            block_tile(ob0, ob1, mb, lb, qb, kl, vl, LUT + 2 * LUTN + x3);
        }
#define MX_EPI_B(o0_, o1_, m_, l_, p_) do { float lt = l_; { auto rr = __builtin_amdgcn_permlane32_swap(__float_as_uint(lt), __float_as_uint(lt), false, false); lt = __uint_as_float(rr[0]) + __uint_as_float(rr[1]); } \
            const float lse2 = m_ + __log2f(lt), lse1 = Lh[(long)(p_) * NH], mm = __builtin_fmaxf(lse1, lse2), e1 = __builtin_amdgcn_exp2f(lse1 - mm), e2 = __builtin_amdgcn_exp2f(lse2 - mm); \
            const float id = __builtin_amdgcn_rcpf(e1 + e2), w1 = e1 * id, w2 = e2 * id * __builtin_amdgcn_rcpf(lt); bf16_t* mrow = Mh + (long)(p_) * MP + 4 * hi; \
            _Pragma("unroll") for (int rq = 0; rq < 4; ++rq) { const u32x2 a0 = *(const u32x2*)(mrow + 8 * rq), a1 = *(const u32x2*)(mrow + 32 + 8 * rq); u32x2 w0, w1_; \
                w0.x = cvtpk(w1 * bf2f(a0.x & 0xffff) + w2 * o0_[4 * rq], w1 * bf2f(a0.x >> 16) + w2 * o0_[4 * rq + 1]); w0.y = cvtpk(w1 * bf2f(a0.y & 0xffff) + w2 * o0_[4 * rq + 2], w1 * bf2f(a0.y >> 16) + w2 * o0_[4 * rq + 3]); \
                w1_.x = cvtpk(w1 * bf2f(a1.x & 0xffff) + w2 * o1_[4 * rq], w1 * bf2f(a1.x >> 16) + w2 * o1_[4 * rq + 1]); w1_.y = cvtpk(w1 * bf2f(a1.y & 0xffff) + w2 * o1_[4 * rq + 2], w1 * bf2f(a1.y >> 16) + w2 * o1_[4 * rq + 3]); \
                *(u32x2*)(mrow + 8 * rq) = w0; *(u32x2*)(mrow + 32 + 8 * rq) = w1_; } } while (0)
        MX_EPI_B(oa0, oa1, ma, la, pa);
        MX_EPI_B(ob0, ob1, mb, lb, pb);
#undef MX_EPI_B
    }
    MX_WAIT_L0();
}

__device__ __forceinline__ void gmlp_unit(const Tensors& T, int b, int ch, int g, MX_LAS char* slot, int lane) {
    const int r32 = lane & 31, hi = lane >> 5;
    const long t0 = (long)b * SEQ + 128 * ch;
    const float* lg = T.ln_g + 64 * g; const float* lb = T.ln_b + 64 * g;
    MX_WAIT_L0();
#pragma unroll 1
    for (int tk = 0; tk < 2; ++tk) {
        const int s = lane + 64 * tk; const bf16_t* vrow = T.PROJ + (t0 + s) * PP + COL_V + 64 * g;
        float x[64]; float sum = 0.f;
#pragma unroll
        for (int c = 0; c < 8; ++c) { const u32x4 w = *(const u32x4*)(vrow + 8 * c);
#pragma unroll
            for (int j = 0; j < 4; ++j) { const float lo = gelu_tanh(bf2f(w[j] & 0xffff)), hh = gelu_tanh(bf2f(w[j] >> 16)); x[8 * c + 2 * j] = lo; x[8 * c + 2 * j + 1] = hh; sum += lo + hh; } }
        const float mu = sum * (1.f / 64.f); float q = 0.f;
#pragma unroll
        for (int d = 0; d < 64; ++d) { x[d] -= mu; q += x[d] * x[d]; }
        const float rstd = __builtin_amdgcn_rsqf(q * (1.f / 64.f) + 1e-6f);
#pragma unroll
        for (int d = 0; d < 64; ++d) { const float vn = x[d] * rstd * lg[d] + lb[d];
            *(MX_LAS unsigned short*)(slot + d * 256 + ((((s >> 3) ^ (d & 15))) << 4) + (s & 7) * 2) = (unsigned short)(cvtpk(vn, vn) & 0xffff); }
    }
    MX_WAIT_L0();
    const bf16_t* W = T.WSP + (long)g * 128 * 128;
#pragma unroll 1
    for (int tt = 0; tt < 4; ++tt) {
        f32x16 z0 = {}, z1 = {};
        const bf16_t* wrow = W + (32 * tt + r32) * 128 + 8 * hi;
        for (int ks = 0; ks <= 2 * tt + 1; ++ks) {
            const bf16x8 bw = *(const bf16x8*)(wrow + 16 * ks);
            const bf16x8 a0 = *(const MX_LAS bf16x8*)(slot + r32 * 256 + (((2 * ks + hi) ^ (r32 & 15)) << 4));
            const bf16x8 a1 = *(const MX_LAS bf16x8*)(slot + (32 + r32) * 256 + (((2 * ks + hi) ^ (r32 & 15)) << 4));
            z0 = __builtin_amdgcn_mfma_f32_32x32x16_bf16(a0, bw, z0, 0, 0, 0);
            z1 = __builtin_amdgcn_mfma_f32_32x32x16_bf16(a1, bw, z1, 0, 0, 0);
        }
        const int t = 32 * tt + r32; const float bs = T.sp_b[g * 128 + t];
        const bf16_t* urow = T.PROJ + (t0 + t) * PP + COL_U + 64 * g + 4 * hi; bf16_t* orow = T.MIX + (t0 + t) * MP + 64 * g + 4 * hi;
#pragma unroll
        for (int rq = 0; rq < 4; ++rq) { const u32x2 u0 = *(const u32x2*)(urow + 8 * rq), u1 = *(const u32x2*)(urow + 32 + 8 * rq); u32x2 w0, w1;
            w0.x = cvtpk(gelu_tanh(bf2f(u0.x & 0xffff)) * (z0[4 * rq] + bs), gelu_tanh(bf2f(u0.x >> 16)) * (z0[4 * rq + 1] + bs)); w0.y = cvtpk(gelu_tanh(bf2f(u0.y & 0xffff)) * (z0[4 * rq + 2] + bs), gelu_tanh(bf2f(u0.y >> 16)) * (z0[4 * rq + 3] + bs));
            w1.x = cvtpk(gelu_tanh(bf2f(u1.x & 0xffff)) * (z1[4 * rq] + bs), gelu_tanh(bf2f(u1.x >> 16)) * (z1[4 * rq + 1] + bs)); w1.y = cvtpk(gelu_tanh(bf2f(u1.y & 0xffff)) * (z1[4 * rq + 2] + bs), gelu_tanh(bf2f(u1.y >> 16)) * (z1[4 * rq + 3] + bs));
            *(u32x2*)(orow + 8 * rq) = w0; *(u32x2*)(orow + 32 + 8 * rq) = w1; }
    }
    MX_WAIT_L0();
}
}
constexpr int NWAVES = 8;
#ifndef MK_N_LAUNCHES
#define MK_N_LAUNCHES 1
#endif
constexpr int N_PHASES = 9;
constexpr int N_LAUNCHES = MK_N_LAUNCHES;

constexpr int BATCH = 16, T = 2048, D = 1024, NIN = 2816, FF = 2816, NGU = 2 * FF;
constexpr int M = BATCH * T;
constexpr float EPS = 1e-6f;

constexpr size_t MiB = 1u << 20;
constexpr size_t WS_CTL = 0, CTL_ZERO_BYTES = 1 * MiB;
constexpr size_t WS_WIN = 2 * MiB, WS_WOUT = 8 * MiB, WS_WGU = 10 * MiB, WS_WDN = 21 * MiB, WS_WSP = 27 * MiB;
constexpr size_t WS_LSE = 28 * MiB;
constexpr size_t WS_FG = 32 * MiB, WS_FU = 44 * MiB, WS_LG = 56 * MiB;
constexpr size_t WS_XN = 68 * MiB;
constexpr size_t WS_PROJ = 132 * MiB, WS_KV = 212 * MiB;
constexpr size_t WS_ACT = WS_PROJ;
constexpr size_t WS_MIX = 308 * MiB;
constexpr size_t WS_Y = 372 * MiB, WS_END = 500 * MiB;
static_assert(WS_WIN + (size_t)NIN * D * 2 <= WS_WOUT && WS_WOUT + (size_t)D * D * 2 <= WS_WGU && WS_WGU + (size_t)NGU * D * 2 <= WS_WDN && WS_WDN + (size_t)D * FF * 2 <= WS_WSP && WS_WSP + 4 * 128 * 128 * 2 <= WS_LSE, "ws map (weights)");
static_assert(WS_LSE + (size_t)M * 12 * 4 <= WS_FG && WS_FG + (size_t)(M / 64) * 2 * FF * 4 <= WS_FU && WS_LG + (size_t)(M / 64) * 2 * FF * 4 <= WS_XN && WS_XN + (size_t)M * D * 2 <= WS_PROJ && WS_PROJ + (size_t)M * 1280 * 2 <= WS_KV && WS_KV + (size_t)M * 1536 * 2 <= WS_MIX && WS_ACT + (size_t)M * FF * 2 <= WS_MIX && WS_MIX + (size_t)M * D * 2 <= WS_Y && WS_Y + (size_t)M * D * 4 <= WS_END, "ws map");
constexpr int CW_TMO = 0, CW_CODE = 1;
constexpr int CW_BAR = 4096;

constexpr int RING_OFF = 0, RING_BYTES = 131072;
constexpr int LUT_OFF = RING_BYTES, LUT_BYTES = 3 * 256 * 4;
constexpr int LDSCTL_OFF = LUT_OFF + LUT_BYTES, MISC_OFF = LDSCTL_OFF + 320;
constexpr int LDS_BYTES = 147456;
static_assert(MISC_OFF + 128 <= LDS_BYTES, "LDS map");

#define GAS __attribute__((address_space(1)))
#define LAS __attribute__((address_space(3)))
typedef unsigned short bf16;
typedef unsigned v4u __attribute__((ext_vector_type(4)));
typedef float f32x4 __attribute__((ext_vector_type(4)));
typedef short bf16x8 __attribute__((ext_vector_type(8)));
typedef GAS unsigned gu32;
typedef GAS unsigned long long gu64;
#define RLX_AGENT __ATOMIC_RELAXED, __HIP_MEMORY_SCOPE_AGENT
#define LDS_WAIT() asm volatile("s_waitcnt lgkmcnt(0)" ::: "memory")
#define VM_WAIT() asm volatile("s_waitcnt vmcnt(0)" ::: "memory")
__device__ __forceinline__ unsigned long long rt() { return __builtin_amdgcn_s_memrealtime(); }
__device__ __forceinline__ unsigned f2bf(float f) { unsigned u = __builtin_bit_cast(unsigned, f); return (u + 0x7fffu + ((u >> 16) & 1u)) >> 16; }
__device__ __forceinline__ unsigned pk2(float lo, float hi) { return f2bf(lo) | (f2bf(hi) << 16); }

#define XB_TMO      128
#define XB_XCNT(j)  (256  + 64 * (j))
#define XB_XSUB(j)  (1280 + 64 * (j))
#define XB_XGEN(j)  (2304 + 64 * (j))
#define XB_TOP      3328
#define XB_TOPGEN   3392
#define XCD_BAR_WORDS 3456
#define XB_SPIN_CAP (1u << 18)

__device__ __forceinline__ unsigned xb_ld(unsigned* p)              { return __hip_atomic_load(p, __ATOMIC_RELAXED, __HIP_MEMORY_SCOPE_AGENT); }
__device__ __forceinline__ unsigned xb_add(unsigned* p, unsigned v) { return __hip_atomic_fetch_add(p, v, __ATOMIC_RELAXED, __HIP_MEMORY_SCOPE_AGENT); }
__device__ __forceinline__ unsigned xb_xcc_id() { return (unsigned)__builtin_amdgcn_s_getreg((3 << 11) | 20) & 0xFu; }
#define XB_SPIN(cond, bar) do { unsigned _sp = 0; while (cond) { __builtin_amdgcn_s_sleep(1); \
    if ((++_sp & 255u) == 0u) { if (xb_ld(&(bar)[XB_TMO])) break; if (_sp > XB_SPIN_CAP) { atomicAdd(&(bar)[XB_TMO], 1u); break; } } } } while (0)

struct XcdBarrier {
    unsigned* bar; unsigned x;
    volatile LAS unsigned* st;
};

__device__ __forceinline__ XcdBarrier xcd_barrier_post(unsigned* bar, volatile LAS unsigned* st) {
    XcdBarrier b; b.bar = bar; b.x = xb_xcc_id(); b.st = st;
    if (threadIdx.x == 0) (void)xb_add(&bar[XB_XCNT(b.x)], 1u);
    return b;
}
__device__ __forceinline__ void xcd_barrier_complete(unsigned* bar, unsigned x, unsigned& nloc, unsigned& nx) {
    const unsigned G = gridDim.x * gridDim.y * gridDim.z;
    unsigned sum, cnt, mine, sp = 0u;
    for (;;) {
        sum = 0u; cnt = 0u; mine = 0u;
#pragma unroll
        for (unsigned j = 0; j < 16; ++j) { const unsigned c = xb_ld(&bar[XB_XCNT(j)]); sum += c; cnt += (c > 0u) ? 1u : 0u; mine = (j == x) ? c : mine; }
        if (sum == G) break;
        __builtin_amdgcn_s_sleep(1);
        if ((++sp & 255u) == 0u) { if (xb_ld(&bar[XB_TMO])) break; if (sp > XB_SPIN_CAP) { atomicAdd(&bar[XB_TMO], 1u); break; } }
    }
    nloc = mine > 0u ? mine : 1u; nx = cnt > 0u ? cnt : 1u;
}

__device__ __forceinline__ void xcd_barrier(const XcdBarrier& b) {
    asm volatile("s_waitcnt vmcnt(0)" ::: "memory");
    __syncthreads();
    if (threadIdx.x == 0) {
        unsigned* bar = b.bar;
        __builtin_amdgcn_s_waitcnt(0);
        unsigned nloc = b.st[0], nx = b.st[1];
        if (nloc == 0u) { xcd_barrier_complete(bar, b.x, nloc, nx); b.st[0] = nloc; b.st[1] = nx; }
        const unsigned old = xb_add(&bar[XB_XSUB(b.x)], 1u);
        const unsigned gen = old / nloc;
        if (old + 1u == (gen + 1u) * nloc) {
            __builtin_amdgcn_fence(__ATOMIC_RELEASE, "agent");
            asm volatile("s_waitcnt vmcnt(0)" ::: "memory");
            const unsigned og = xb_add(&bar[XB_TOP], 1u);
            const unsigned tg = og / nx;
            if (og + 1u == (tg + 1u) * nx) xb_add(&bar[XB_TOPGEN], 1u);
            else XB_SPIN(xb_ld(&bar[XB_TOPGEN]) == tg, bar);
            __builtin_amdgcn_fence(__ATOMIC_ACQUIRE, "agent");
            xb_add(&bar[XB_XGEN(b.x)], 1u);
            asm volatile("s_waitcnt vmcnt(0)" ::: "memory");
        } else {
            XB_SPIN(xb_ld(&bar[XB_XGEN(b.x)]) == gen, bar);
            __builtin_amdgcn_fence(__ATOMIC_ACQUIRE, "agent");
            asm volatile("s_waitcnt vmcnt(0)" ::: "memory");
        }
    }
    __syncthreads();
}


struct Frame {
    LAS unsigned char* lds;
    volatile LAS unsigned* MISC;
    gu32* ctl;
    int tid, lane, wave;
    int vcu, G;
};

__device__ __forceinline__ float wave_sum(float v) {
#pragma unroll
    for (int o = 1; o < 64; o <<= 1) v += __shfl_xor(v, o);
    return v;
}
__device__ __forceinline__ void p0_transpose_item(const float* W, int K, int N, bf16* WT, int k0, int n0, int drow0, LAS float* scr, int lane) {
#pragma unroll 8
    for (int i = 0; i < 32; ++i) { const int kk = 2 * i + (lane >> 5); scr[kk * 33 + (lane & 31)] = W[(size_t)(k0 + kk) * N + n0 + (lane & 31)]; }
    LDS_WAIT(); asm volatile("" ::: "memory");
    const int c = lane & 7;
#pragma unroll
    for (int j = 0; j < 4; ++j) { const int n = (lane >> 3) + 8 * j; const LAS float* s = scr + (8 * c) * 33 + n;
        v4u o; o.x = pk2(s[0 * 33], s[1 * 33]); o.y = pk2(s[2 * 33], s[3 * 33]); o.z = pk2(s[4 * 33], s[5 * 33]); o.w = pk2(s[6 * 33], s[7 * 33]);
        *(GAS v4u*)(WT + (size_t)(drow0 + n) * K + k0 + 8 * c) = o; }
    LDS_WAIT(); asm volatile("" ::: "memory");
}
__device__ __forceinline__ void rms_row_to_bf16(int lane, const float* xrow, const float* g, bf16* orow) {
    const GAS f32x4* xr = (const GAS f32x4*)xrow + lane; const GAS f32x4* gr = (const GAS f32x4*)g + lane;
    f32x4 v[4]; float s = 0.f;
#pragma unroll
    for (int j = 0; j < 4; ++j) { v[j] = xr[64 * j]; s += (v[j].x * v[j].x + v[j].y * v[j].y) + (v[j].z * v[j].z + v[j].w * v[j].w); }
    const float r = 1.f / sqrtf(wave_sum(s) * (1.f / D) + EPS);
    GAS unsigned long long* o8 = (GAS unsigned long long*)orow + lane;
#pragma unroll
    for (int j = 0; j < 4; ++j) { const f32x4 gg = gr[64 * j]; o8[64 * j] = (unsigned long long)pk2(v[j].x * r * gg.x, v[j].y * r * gg.y) | ((unsigned long long)pk2(v[j].z * r * gg.z, v[j].w * r * gg.w) << 32); }
}

struct Args { const float* in[17]; float* out; unsigned char* ws; int ph_lo, ph_hi, li, pad; };

__global__ void __launch_bounds__(NWAVES * 64, 2) mk_fwd(Args args) {
    extern __shared__ __attribute__((aligned(16))) unsigned char lds[];
    Frame F;
    F.lds = (LAS unsigned char*)lds;
    F.MISC = (volatile LAS unsigned*)(F.lds + MISC_OFF);
    F.tid = threadIdx.x; F.lane = F.tid & 63; F.wave = __builtin_amdgcn_readfirstlane(F.tid >> 6);
    F.G = gridDim.x; { const int bx = blockIdx.x; F.vcu = (F.G % 8 == 0) ? (bx % 8) * (F.G / 8) + bx / 8 : bx; }
    unsigned char* ws = args.ws;
    F.ctl = (gu32*)(ws + WS_CTL);
    const float* x = args.in[0]; const float* g_mix_pre = args.in[1]; const float* g_mix_post = args.in[2]; const float* g_ffn_pre = args.in[3]; const float* g_ffn_post = args.in[4];
    const float* w_in = args.in[5]; const float* ln_g = args.in[6]; const float* ln_b = args.in[7]; const float* sp_w = args.in[8]; const float* sp_b = args.in[9]; const float* rel_bias = args.in[10];
    const float* w_out = args.in[11]; const float* w_gate = args.in[12]; const float* w_up = args.in[13]; const float* conv_w = args.in[14]; const float* conv_b = args.in[15]; const float* w_down = args.in[16];
    float* out = args.out;
    bf16* Win_t = (bf16*)(ws + WS_WIN); bf16* Wout_t = (bf16*)(ws + WS_WOUT); bf16* Wgu_t = (bf16*)(ws + WS_WGU); bf16* Wdn_t = (bf16*)(ws + WS_WDN); bf16* Wsp = (bf16*)(ws + WS_WSP);
    bf16* XN = (bf16*)(ws + WS_XN); bf16* PROJ = (bf16*)(ws + WS_PROJ); bf16* KV = (bf16*)(ws + WS_KV); bf16* ACT = (bf16*)(ws + WS_ACT); bf16* MIX = (bf16*)(ws + WS_MIX);
    float* Y = (float*)(ws + WS_Y); float* LSE = (float*)(ws + WS_LSE); float* FG = (float*)(ws + WS_FG); float* FU = (float*)(ws + WS_FU); float* LG = (float*)(ws + WS_LG);

    for (int u = F.tid; u < (LDS_BYTES - LDSCTL_OFF) / 4; u += NWAVES * 64) ((LAS unsigned*)(F.lds + LDSCTL_OFF))[u] = 0u;
    __syncthreads();
    XcdBarrier bar; bar.bar = (unsigned*)(F.ctl + CW_BAR); bar.x = 0; bar.st = nullptr;
    if (N_LAUNCHES == 1) bar = xcd_barrier_post((unsigned*)(F.ctl + CW_BAR), F.MISC + 8);
#define GRID_BAR() do { if (N_LAUNCHES == 1) xcd_barrier(bar); } while (0)
    const int lo = args.ph_lo, hi = args.ph_hi;
#ifndef PHASE_MASK
#define PHASE_MASK 0x1ff
#endif
#define IN(k) (((PHASE_MASK >> (k)) & 1) && lo <= (k) && (k) < hi)
#ifndef REPEAT_MASK
#define REPEAT_MASK 0
#endif
#define PH_BEGIN(k) if (IN(k)) { for (int rep_ = 0; rep_ <= ((REPEAT_MASK >> (k)) & 1); ++rep_) {
#define PH_END(k) if (rep_ < ((REPEAT_MASK >> (k)) & 1)) GRID_BAR(); } if (IN((k) + 1)) GRID_BAR(); }
    const int gw = F.vcu * NWAVES + F.wave, NGW = F.G * NWAVES;

    PH_BEGIN(0)
        LAS float* scr = (LAS float*)(F.lds + RING_OFF + F.wave * 16384);
        constexpr int NB_IN = NIN / 32, NB_D = D / 32, NB_FF = FF / 32;
        constexpr int I_IN = (D / 64) * NB_IN, I_OUT = (D / 64) * NB_D, I_G = (D / 64) * NB_FF, I_DN = (FF / 64) * NB_D;
        constexpr int NITEMS = I_IN + I_OUT + 2 * I_G + I_DN;
        for (int it = gw; it < NITEMS; it += NGW) {
            int r = it;
            if (r < I_IN) { const int kb = r / NB_IN, nb = r % NB_IN; p0_transpose_item(w_in, D, NIN, Win_t, 64 * kb, 32 * nb, 32 * nb, scr, F.lane); continue; } r -= I_IN;
            if (r < I_OUT) { const int kb = r / NB_D, nb = r % NB_D; p0_transpose_item(w_out, D, D, Wout_t, 64 * kb, 32 * nb, 32 * nb, scr, F.lane); continue; } r -= I_OUT;
            if (r < I_G) { const int kb = r / NB_FF, nb = r % NB_FF, n0 = 32 * nb; p0_transpose_item(w_gate, D, FF, Wgu_t, 64 * kb, n0, 256 * (n0 >> 7) + (n0 & 127), scr, F.lane); continue; } r -= I_G;
            if (r < I_G) { const int kb = r / NB_FF, nb = r % NB_FF, n0 = 32 * nb; p0_transpose_item(w_up, D, FF, Wgu_t, 64 * kb, n0, 256 * (n0 >> 7) + 128 + (n0 & 127), scr, F.lane); continue; } r -= I_G;
            { const int kb = r / NB_D, nb = r % NB_D; p0_transpose_item(w_down, FF, D, Wdn_t, 64 * kb, 32 * nb, 32 * nb, scr, F.lane); }
        }
        for (int i = blockIdx.x * 512 + F.tid; i < 4 * 128 * 128; i += F.G * 512) { const int t = (i >> 7) & 127, s = i & 127; Wsp[i] = (bf16)f2bf(s <= t ? sp_w[i] : 0.f); }
        for (int m = gw; m < M; m += NGW) rms_row_to_bf16(F.lane, x + (size_t)m * D, g_mix_pre, XN + (size_t)m * D);
    PH_END(0)
    PH_BEGIN(1)
        pg8::Gemm g{XN, Win_t, M, NIN, D}; pg8::StaticOrder S; S.init(M, NIN, F.G, (int)blockIdx.x);
        pg8::EpiProj E{PROJ, 1280, mixer::C2, KV};
        pg8::gemm_phase<pg8::EpiProj, pg8::StaticOrder, PG8_ALIGN, PG8_SP2>(F.lds + RING_OFF, g, S, E);
    PH_END(1)
    PH_BEGIN(2)
        mixer::Tensors MT{PROJ, KV, MIX, LSE, rel_bias, Wsp, ln_g, ln_b, sp_b};
#ifndef NO_GMLP
        if (args.pad != 2)
        for (int i = F.wave * F.G + F.vcu; i < BATCH * 16 * 4; i += NGW) mixer::gmlp_unit(MT, i >> 6, (i >> 2) & 15, i & 3, (LAS char*)(F.lds + RING_OFF) + F.wave * mixer::SLOT, F.lane);
#endif
#ifndef NO_ATTN
        const int NU = BATCH * 12 * 4, per = (NU + F.G - 1) / F.G;
        for (int i = 0; i < per && args.pad != 1; ++i) { const int U = (F.G == 256) ? (((F.vcu >> 5) * per + i) * 32 + (F.vcu & 31)) : F.vcu * per + i; if (U >= NU) break;
            mixer::attn_unit(MT, (U >> 2) / 12, (U >> 2) % 12, U & 3, (LAS char*)(F.lds + RING_OFF), (LAS float*)(F.lds + LUT_OFF), F.wave, F.lane); }
#endif
        asm volatile("s_waitcnt vmcnt(0) lgkmcnt(0)" ::: "memory"); __syncthreads();
    PH_END(2)
    PH_BEGIN(3)
        pg8::Gemm g{MIX, Wout_t, M, D, D}; pg8::StaticOrder S; S.init(M, D, F.G, (int)blockIdx.x);
        pg8::EpiF32 E{Y, D};
        pg8::gemm_phase<pg8::EpiF32, pg8::StaticOrder, PG8_ALIGN, PG8_SP2>(F.lds + RING_OFF, g, S, E);
    PH_END(3)
    PH_BEGIN(4)
        for (int m = gw; m < M; m += NGW) {
            const GAS f32x4* yr = (const GAS f32x4*)(Y + (size_t)m * D) + F.lane; const GAS f32x4* xr = (const GAS f32x4*)(x + (size_t)m * D) + F.lane;
            const GAS f32x4* g2 = (const GAS f32x4*)g_mix_post + F.lane; const GAS f32x4* g3 = (const GAS f32x4*)g_ffn_pre + F.lane;
            f32x4 v[4]; float s = 0.f;
#pragma unroll
            for (int j = 0; j < 4; ++j) { v[j] = yr[64 * j]; s += (v[j].x * v[j].x + v[j].y * v[j].y) + (v[j].z * v[j].z + v[j].w * v[j].w); }
            const float r = 1.f / sqrtf(wave_sum(s) * (1.f / D) + EPS); float s2 = 0.f;
#pragma unroll
            for (int j = 0; j < 4; ++j) { v[j] = xr[64 * j] + v[j] * r * g2[64 * j]; s2 += (v[j].x * v[j].x + v[j].y * v[j].y) + (v[j].z * v[j].z + v[j].w * v[j].w); }
            const float r2 = 1.f / sqrtf(wave_sum(s2) * (1.f / D) + EPS);
            GAS f32x4* orow = (GAS f32x4*)(out + (size_t)m * D) + F.lane; GAS unsigned long long* o8 = (GAS unsigned long long*)(XN + (size_t)m * D) + F.lane;
#pragma unroll
            for (int j = 0; j < 4; ++j) { orow[64 * j] = v[j]; const f32x4 gg = g3[64 * j];
                o8[64 * j] = (unsigned long long)pk2(v[j].x * r2 * gg.x, v[j].y * r2 * gg.y) | ((unsigned long long)pk2(v[j].z * r2 * gg.z, v[j].w * r2 * gg.w) << 32); }
        }
    PH_END(4)
    PH_BEGIN(5)
        pg8::Gemm g{XN, Wgu_t, M, NGU, D}; pg8::StaticOrder S; S.init(M, NGU, F.G, (int)blockIdx.x);
        pg8::EpiGateUp E{ACT, FF, conv_w, conv_b, FG, FU, LG};
        pg8::gemm_phase<pg8::EpiGateUp, pg8::StaticOrder, PG8_ALIGN, PG8_SP2>(F.lds + RING_OFF, g, S, E);
    PH_END(5)
    PH_BEGIN(6)
        constexpr int NG = M / 64, C4 = FF / 4;
        for (int i = blockIdx.x * 512 + F.tid; i < NG * C4; i += F.G * 512) {
            const int grp = i / C4, c = (i % C4) * 4; if ((grp & 31) == 0) continue;
            const f32x4 g0 = *(const f32x4*)(FG + (size_t)(grp * 2) * FF + c), g1 = *(const f32x4*)(FG + (size_t)(grp * 2 + 1) * FF + c);
            const f32x4 u0 = *(const f32x4*)(FU + (size_t)(grp * 2) * FF + c), u1 = *(const f32x4*)(FU + (size_t)(grp * 2 + 1) * FF + c);
            const f32x4 hm2 = *(const f32x4*)(LG + (size_t)(grp * 2 - 2) * FF + c), hm1 = *(const f32x4*)(LG + (size_t)(grp * 2 - 1) * FF + c);
            const f32x4 w0 = *(const f32x4*)(conv_w + c), w1 = *(const f32x4*)(conv_w + FF + c), w2 = *(const f32x4*)(conv_w + 2 * FF + c), bb = *(const f32x4*)(conv_b + c);
            float a0[4], a1[4];
#pragma unroll
            for (int j = 0; j < 4; ++j) { a0[j] = pg8::gelu_tanh(bb[j] + w2[j] * g0[j] + w1[j] * hm1[j] + w0[j] * hm2[j]) * u0[j]; a1[j] = pg8::gelu_tanh(bb[j] + w2[j] * g1[j] + w1[j] * g0[j] + w0[j] * hm1[j]) * u1[j]; }
            *(unsigned long long*)(ACT + (size_t)(grp * 64) * FF + c) = (unsigned long long)pk2(a0[0], a0[1]) | ((unsigned long long)pk2(a0[2], a0[3]) << 32);
            *(unsigned long long*)(ACT + (size_t)(grp * 64 + 1) * FF + c) = (unsigned long long)pk2(a1[0], a1[1]) | ((unsigned long long)pk2(a1[2], a1[3]) << 32);
        }
    PH_END(6)
    PH_BEGIN(7)
        pg8::Gemm g{ACT, Wdn_t, M, D, FF}; pg8::StaticOrder S; S.init(M, D, F.G, (int)blockIdx.x);
        pg8::EpiF32 E{Y, D};
        pg8::gemm_phase<pg8::EpiF32, pg8::StaticOrder, PG8_ALIGN, PG8_SP2>(F.lds + RING_OFF, g, S, E);
    PH_END(7)
    PH_BEGIN(8)
        for (int m = gw; m < M; m += NGW) {
            const GAS f32x4* yr = (const GAS f32x4*)(Y + (size_t)m * D) + F.lane; GAS f32x4* orow = (GAS f32x4*)(out + (size_t)m * D) + F.lane;
            const GAS f32x4* g4 = (const GAS f32x4*)g_ffn_post + F.lane;
            f32x4 v[4]; float s = 0.f;
#pragma unroll
            for (int j = 0; j < 4; ++j) { v[j] = yr[64 * j]; s += (v[j].x * v[j].x + v[j].y * v[j].y) + (v[j].z * v[j].z + v[j].w * v[j].w); }
            const float r = 1.f / sqrtf(wave_sum(s) * (1.f / D) + EPS);
#pragma unroll
            for (int j = 0; j < 4; ++j) orow[64 * j] = orow[64 * j] + v[j] * r * g4[64 * j];
        }
    } }
#undef IN
#undef GRID_BAR
}

extern "C" void kernel_launch(void* const* d_in, const int* in_sizes, int n_in, void* d_out, int out_size, void* d_ws, size_t ws_size, hipStream_t stream) {
    static int grid = 0;
    if (grid == 0) {
        if (n_in != 17 || in_sizes[0] != M * D || out_size != M * D || ws_size < WS_END) { fprintf(stderr, "kernel_launch: unexpected shapes: n_in %d in0 %d out %d ws %zu (need %zu)\n", n_in, n_in > 0 ? in_sizes[0] : -1, out_size, ws_size, (size_t)WS_END); grid = -1; return; }
        int dev = 0, cus = 0, per_cu = 0;
        if (hipGetDevice(&dev) != hipSuccess || hipDeviceGetAttribute(&cus, hipDeviceAttributeMultiprocessorCount, dev) != hipSuccess) { grid = -1; return; }
        if (hipFuncSetAttribute((const void*)mk_fwd, hipFuncAttributeMaxDynamicSharedMemorySize, LDS_BYTES) != hipSuccess) { fprintf(stderr, "kernel_launch: hipFuncSetAttribute failed\n"); grid = -1; return; }
        if (hipOccupancyMaxActiveBlocksPerMultiprocessor(&per_cu, (const void*)mk_fwd, NWAVES * 64, LDS_BYTES) != hipSuccess || per_cu < 1) fprintf(stderr, "kernel_launch: note: occupancy query reports %d workgroups per CU\n", per_cu);
        (void)hipGetLastError();
        grid = cus;
    }
    if (grid < 0) return;
    if (hipMemsetAsync((char*)d_ws + WS_CTL, 0, CTL_ZERO_BYTES, stream) != hipSuccess) { fprintf(stderr, "kernel_launch: hipMemsetAsync failed\n"); return; }
    Args a{};
    for (int i = 0; i < 17; ++i) a.in[i] = (const float*)d_in[i];
    a.out = (float*)d_out; a.ws = (unsigned char*)d_ws;
    for (int li = 0; li < N_LAUNCHES; ++li) {
        a.ph_lo = (N_LAUNCHES == 1) ? 0 : li; a.ph_hi = (N_LAUNCHES == 1) ? N_PHASES : li + 1; a.li = li;
        hipLaunchKernelGGL(mk_fwd, dim3(grid), dim3(NWAVES * 64), LDS_BYTES, stream, a);
#ifdef HOST_REPEAT_MASK
#ifndef HOST_REPEAT_SUB
#define HOST_REPEAT_SUB 0
#endif
        if (N_LAUNCHES > 1 && ((HOST_REPEAT_MASK >> li) & 1)) { a.pad = HOST_REPEAT_SUB; hipLaunchKernelGGL(mk_fwd, dim3(grid), dim3(NWAVES * 64), LDS_BYTES, stream, a); a.pad = 0; }
#endif
        const hipError_t le = hipPeekAtLastError();
        if (le != hipSuccess) { fprintf(stderr, "kernel_launch: launch %d failed: %s\n", li, hipGetErrorName(le)); break; }
    }
}
```

```cpp
#include <hip/hip_runtime.h>
#include <cstdio>
#include <cstdint>
#include <cmath>
namespace pg8 {
#define PG8_LAS __attribute__((address_space(3)))
typedef unsigned short bf16_t;
typedef short bf16x8 __attribute__((ext_vector_type(8)));
typedef float f32x4 __attribute__((ext_vector_type(4)));
typedef unsigned u32x4 __attribute__((ext_vector_type(4)));
constexpr int BM = 256, BK = 64, HALF = 128, HTB = HALF * BK * 2  , STAGE_BYTES = 8 * HTB, NXCD = 8, WGM = 8;

__host__ __device__ __forceinline__ int lds_byte(int r, int c) { const int st = (r >> 4) * 2 + (c >> 5), rr = r & 15, cc = c & 31, ob = rr * 64 + cc * 2; return st * 1024 + (ob ^ (((ob >> 9) & 1) << 5)); }
__host__ __device__ __forceinline__ void stage_rc(int b, int& R, int& C) { const int st = b / 1024, sb = b % 1024, swz = sb ^ (((sb >> 9) & 1) << 5); R = (st >> 1) * 16 + swz / 64; C = (st & 1) * 32 + (swz % 64) / 2; }
__host__ __device__ __forceinline__ int perm32(int rho) { const int n = rho >> 4, i = rho & 15; return 8 * (i >> 2) + 4 * n + (i & 3); }

struct Unit { int pm, pn; };
struct Gemm { const bf16_t* A; const bf16_t* Bt; int M, N, K; };

struct StaticOrder {
    int nM, nN, nwg, G, c;
    __host__ __device__ void init(int M, int N, int G_, int c_) { nM = M / BM; nN = N / BM; nwg = nM * nN; G = G_; c = c_; }
    __host__ __device__ bool next(int i, Unit& u) const {
        const long L = (long)i * G + c; if (L >= nwg) return false;
        int wgid = (int)L; { const int q = nwg / NXCD, r = nwg % NXCD, xcd = wgid % NXCD, off = wgid / NXCD; wgid = (xcd < r ? xcd * (q + 1) : r * (q + 1) + (xcd - r) * q) + off; }
        const int nig = WGM * nN, gid = wgid / nig, fm = gid * WGM, gsz = (nM - fm) < WGM ? (nM - fm) : WGM;
        u.pm = fm + ((wgid % nig) % gsz); u.pn = (wgid % nig) / gsz; return true;
    }
    __device__ __forceinline__ void a_ready(const Unit&) const {}
    __device__ __forceinline__ void done(const Unit&) const {}
};

__device__ __forceinline__ unsigned cvt_pk_bf16(float lo, float hi) { unsigned r; asm volatile("v_cvt_pk_bf16_f32 %0, %1, %2" : "=v"(r) : "v"(lo), "v"(hi)); return r; }
typedef float f32x2 __attribute__((ext_vector_type(2)));
__device__ __forceinline__ f32x2 gelu_pk(f32x2 v) {
    const f32x2 av = __builtin_elementwise_abs(v), d = av * 0.2316418882f + 1.0f;
    f32x2 t; t.x = __builtin_amdgcn_rcpf(d.x); t.y = __builtin_amdgcn_rcpf(d.y);
    f32x2 q = t * 0.5307027145f + (-0.7265760135f); q = q * t + 0.7107068705f; q = q * t + (-0.142248368f); q = q * t + 0.127414796f; q = q * t;
    const f32x2 s = (v * v) * (-0.72134752044f);
    f32x2 e; e.x = __builtin_amdgcn_exp2f(s.x); e.y = __builtin_amdgcn_exp2f(s.y);
    const f32x2 m = v * (q * e), r = v - m;
    f32x2 o; o.x = v.x < 0.f ? m.x : r.x; o.y = v.y < 0.f ? m.y : r.y; return o;
}

template <int ACT  > struct EpiBf16 {
    static constexpr bool PERM = true, AFTER_DRAIN = false; static_assert(ACT == 0 || ACT == 1, "EpiBf16: ACT is 0 (none) or 1 (gelu_pk)");
    bf16_t* O; int ldc; const float* bias; int split_cols; size_t split_stride; float scale0;
    __device__ __forceinline__ void operator()(const f32x4 (&acc)[2][2][4][2], const Unit& u, int wr, int wc, int fr, int fq) const {
        const int row0 = u.pm * BM + wr * 64 + fr; int colt = u.pn * BM; bf16_t* base = O;
        float sc = 1.f; if (split_cols) { const int t = colt / split_cols; base += (size_t)t * split_stride; colt -= t * split_cols; if (t == 0) sc = scale0; }
        const int col0 = colt + wc * 32 + 8 * fq, bcol0 = u.pn * BM + wc * 32 + 8 * fq;
        f32x4 bv[2][2];
#pragma unroll
        for (int bj = 0; bj < 2; ++bj)
#pragma unroll
            for (int n = 0; n < 2; ++n) bv[bj][n] = bias ? *(const f32x4*)(bias + bcol0 + bj * HALF + 4 * n) : (f32x4){0.f, 0.f, 0.f, 0.f};
#pragma unroll
        for (int ai = 0; ai < 2; ++ai)
#pragma unroll
            for (int m = 0; m < 4; ++m) { bf16_t* rowp = base + (size_t)(row0 + ai * HALF + m * 16) * ldc + col0;
#pragma unroll
                for (int bj = 0; bj < 2; ++bj) { f32x4 v0 = acc[ai][bj][m][0] + bv[bj][0], v1 = acc[ai][bj][m][1] + bv[bj][1];
                    if (ACT == 1) { f32x2 a = gelu_pk((f32x2){v0[0], v0[1]}), b = gelu_pk((f32x2){v0[2], v0[3]}), c = gelu_pk((f32x2){v1[0], v1[1]}), d = gelu_pk((f32x2){v1[2], v1[3]});
                        v0 = (f32x4){a.x, a.y, b.x, b.y}; v1 = (f32x4){c.x, c.y, d.x, d.y}; }
                    v0 = v0 * sc; v1 = v1 * sc; u32x4 w; w.x = cvt_pk_bf16(v0[0], v0[1]); w.y = cvt_pk_bf16(v0[2], v0[3]); w.z = cvt_pk_bf16(v1[0], v1[1]); w.w = cvt_pk_bf16(v1[2], v1[3]);
                    *(u32x4*)(rowp + bj * HALF) = w; } }
    }
};

struct PanelStats {
    unsigned* xbuf;
    unsigned* cnt;
    unsigned* tmo;
    int ntn; float eps;
    unsigned code;
    __device__ __forceinline__ bool run(const f32x4 (&v)[2][2][4][2], const Unit& u, int wr, int wc, int fr, int fq, PG8_LAS unsigned char* lds, int wid, int lane) const {
        typedef float f32x2v __attribute__((ext_vector_type(2)));
        PG8_LAS f32x2v* P = (PG8_LAS f32x2v*)lds;
        PG8_LAS f32x2v* S = (PG8_LAS f32x2v*)(lds + 8192);
        PG8_LAS unsigned* flag = (PG8_LAS unsigned*)(lds + 8192 + 2048);
#pragma unroll
        for (int ai = 0; ai < 2; ++ai)
#pragma unroll
            for (int m = 0; m < 4; ++m) {
                float s = 0.f;
#pragma unroll
                for (int bj = 0; bj < 2; ++bj)
#pragma unroll
                    for (int n = 0; n < 2; ++n) { const f32x4 x = v[ai][bj][m][n]; s += (x[0] + x[1]) + (x[2] + x[3]); }
                s += __shfl_xor(s, 16); s += __shfl_xor(s, 32);
                const float mw = s * (1.0f / 64.0f); float q = 0.f;
#pragma unroll
                for (int bj = 0; bj < 2; ++bj)
#pragma unroll
                    for (int n = 0; n < 2; ++n) { const f32x4 d = v[ai][bj][m][n] - mw; q += (d[0] * d[0] + d[1] * d[1]) + (d[2] * d[2] + d[3] * d[3]); }
                q += __shfl_xor(q, 16); q += __shfl_xor(q, 32);
                if (fq == 0) P[(ai * HALF + wr * 64 + m * 16 + fr) * 4 + wc] = (f32x2v){mw, q};
            }
        asm volatile("s_waitcnt lgkmcnt(0)" ::: "memory"); __builtin_amdgcn_s_barrier(); asm volatile("" ::: "memory");
#if defined(BROKEN_EXCHANGE_NO_WAIT)
#warning BROKEN CONTROL BUILD: the row-statistics exchange does not wait; results are wrong by design
        if (blockIdx.x >= 64) { const long long t0_ = clock64(); while (clock64() - t0_ < 60000) __builtin_amdgcn_s_sleep(8); }
#endif
        const int row = wid * 32 + (lane & 31);
        if (lane < 32) {
            const f32x2v a = P[row * 4 + 0], b = P[row * 4 + 1], c = P[row * 4 + 2], d = P[row * 4 + 3];
            const float mt = (a.x + b.x + c.x + d.x) * 0.25f;
            const float da = a.x - mt, db = b.x - mt, dc = c.x - mt, dd = d.x - mt;
            const float m2 = (a.y + b.y) + (c.y + d.y) + 64.0f * ((da * da + db * db) + (dc * dc + dd * dd));
            unsigned long long* slot = (unsigned long long*)xbuf + ((size_t)(u.pm * BM + row) * 4 + u.pn);
            __hip_atomic_store(slot, ((unsigned long long)__float_as_uint(m2) << 32) | __float_as_uint(mt), __ATOMIC_RELAXED, __HIP_MEMORY_SCOPE_AGENT);
        }
        asm volatile("s_waitcnt vmcnt(0)" ::: "memory");
        if (lane == 0) __hip_atomic_fetch_add(cnt + 64 * u.pm, 1u, __ATOMIC_RELAXED, __HIP_MEMORY_SCOPE_AGENT);
        if (wid == 0) {
            bool dead = false; const unsigned long long t0 = __builtin_amdgcn_s_memrealtime(); const unsigned want = 8u * (unsigned)ntn;
            for (;;) {
#if defined(BROKEN_EXCHANGE_NO_WAIT)
                break;
#endif
                if ((unsigned)__builtin_amdgcn_readfirstlane(__hip_atomic_load(cnt + 64 * u.pm, __ATOMIC_RELAXED, __HIP_MEMORY_SCOPE_AGENT)) >= want) break;
                if (__builtin_amdgcn_s_memrealtime() - t0 > 2000000ull) {
                    if (lane == 0) { unsigned expect = 0u; __hip_atomic_compare_exchange_strong(tmo + 1, &expect, code | (unsigned)(u.pm & 0xff), __ATOMIC_RELAXED, __ATOMIC_RELAXED, __HIP_MEMORY_SCOPE_AGENT);
                                     __hip_atomic_store(tmo, 1u, __ATOMIC_RELAXED, __HIP_MEMORY_SCOPE_AGENT); }
                    dead = true; break; }
                __builtin_amdgcn_s_sleep(2);
            }
            __builtin_amdgcn_fence(__ATOMIC_ACQUIRE, "agent");
            if (lane == 0) flag[0] = dead ? 1u : 0u;
        }
        asm volatile("s_waitcnt vmcnt(0) lgkmcnt(0)" ::: "memory"); __builtin_amdgcn_s_barrier(); asm volatile("" ::: "memory");
        const bool bad = flag[0] != 0u;
        if (lane < 32) {
            const unsigned long long* slot = (const unsigned long long*)xbuf + (size_t)(u.pm * BM + row) * 4; float mt[4], m2[4]; float ms = 0.f;
#pragma unroll
            for (int t = 0; t < 4; ++t) { if (t < ntn) { const unsigned long long w = __hip_atomic_load(slot + t, __ATOMIC_RELAXED, __HIP_MEMORY_SCOPE_AGENT); mt[t] = __uint_as_float((unsigned)w); m2[t] = __uint_as_float((unsigned)(w >> 32)); } else { mt[t] = 0.f; m2[t] = 0.f; } ms += mt[t]; }
            const float mean = ms / (float)ntn; float q = 0.f;
#pragma unroll
            for (int t = 0; t < 4; ++t) if (t < ntn) { const float dm = mt[t] - mean; q += m2[t] + 256.0f * dm * dm; }
            S[row] = (f32x2v){mean, 1.0f / sqrtf(q / (256.0f * (float)ntn) + eps)};
        }
        asm volatile("s_waitcnt lgkmcnt(0)" ::: "memory"); __builtin_amdgcn_s_barrier(); asm volatile("" ::: "memory");
        return bad;
    }
};
struct EpiLnRes {
    static constexpr bool PERM = false, AFTER_DRAIN = true;
    const float* base; float* out; int ldc; const float* bias; PanelStats st; unsigned poison;
    __device__ __forceinline__ void fused(f32x4 (&acc)[2][2][4][2], const Unit& u, int wr, int wc, int fr, int fq, PG8_LAS unsigned char* lds, int wid, int lane) const {
        typedef float f32x2v __attribute__((ext_vector_type(2)));
        const PG8_LAS f32x2v* S = (const PG8_LAS f32x2v*)(lds + 8192);
        const int col0 = u.pn * BM + wc * 32 + 4 * fq;
#pragma unroll
        for (int bj = 0; bj < 2; ++bj)
#pragma unroll
            for (int n = 0; n < 2; ++n) { const f32x4 bv = bias ? *(const f32x4*)(bias + col0 + bj * HALF + n * 16) : (f32x4){0.f, 0.f, 0.f, 0.f};
#pragma unroll
                for (int ai = 0; ai < 2; ++ai)
#pragma unroll
                    for (int m = 0; m < 4; ++m) acc[ai][bj][m][n] += bv; }
        f32x4 pre[4][2][2];
#pragma unroll
        for (int m = 0; m < 4; ++m) { const size_t off = (size_t)(u.pm * BM + wr * 64 + m * 16 + fr) * ldc + col0;
#pragma unroll
            for (int bj = 0; bj < 2; ++bj)
#pragma unroll
                for (int n = 0; n < 2; ++n) pre[m][bj][n] = *(const f32x4*)(base + off + bj * HALF + n * 16); }
        const bool bad = st.run(acc, u, wr, wc, fr, fq, lds, wid, lane) || poison != 0u;
        const float qnan = __builtin_nanf("");
#pragma unroll
        for (int ai = 0; ai < 2; ++ai)
#pragma unroll
            for (int m = 0; m < 4; ++m) { const int r = ai * HALF + wr * 64 + m * 16 + fr; const f32x2v sr = S[r]; const size_t off = (size_t)(u.pm * BM + r) * ldc + col0;
#pragma unroll
                for (int bj = 0; bj < 2; ++bj)
#pragma unroll
                    for (int n = 0; n < 2; ++n) { const f32x4 bs = ai == 0 ? pre[m][bj][n] : *(const f32x4*)(base + off + bj * HALF + n * 16); f32x4 o = bs + (acc[ai][bj][m][n] - sr.x) * sr.y;
                        if (bad) o = (f32x4){qnan, qnan, qnan, qnan}; *(f32x4*)(out + off + bj * HALF + n * 16) = o; }
                if (m & 1) asm volatile("" ::: "memory"); }
    }
};
struct EpiLnResLn {
    static constexpr bool PERM = false, AFTER_DRAIN = true;
    const float* base; float* out; bf16_t* xn; int ldc; const float* bias; PanelStats st1, st2; unsigned poison;
    __device__ __forceinline__ void fused(f32x4 (&acc)[2][2][4][2], const Unit& u, int wr, int wc, int fr, int fq, PG8_LAS unsigned char* lds, int wid, int lane) const {
        typedef float f32x2v __attribute__((ext_vector_type(2))); typedef unsigned u32x2v __attribute__((ext_vector_type(2)));
        const PG8_LAS f32x2v* S = (const PG8_LAS f32x2v*)(lds + 8192);
        const int col0 = u.pn * BM + wc * 32 + 4 * fq;
#pragma unroll
        for (int bj = 0; bj < 2; ++bj)
#pragma unroll
            for (int n = 0; n < 2; ++n) { const f32x4 bv = bias ? *(const f32x4*)(bias + col0 + bj * HALF + n * 16) : (f32x4){0.f, 0.f, 0.f, 0.f};
#pragma unroll
                for (int ai = 0; ai < 2; ++ai)
#pragma unroll
                    for (int m = 0; m < 4; ++m) acc[ai][bj][m][n] += bv; }
        bool bad = st1.run(acc, u, wr, wc, fr, fq, lds, wid, lane) || poison != 0u;
        const float qnan = __builtin_nanf("");
#pragma unroll
        for (int ai = 0; ai < 2; ++ai)
#pragma unroll
            for (int m = 0; m < 4; ++m) { const int r = ai * HALF + wr * 64 + m * 16 + fr; const f32x2v sr = S[r]; const size_t off = (size_t)(u.pm * BM + r) * ldc + col0;
#pragma unroll
                for (int bj = 0; bj < 2; ++bj)
#pragma unroll
                    for (int n = 0; n < 2; ++n) { const f32x4 bs = *(const f32x4*)(base + off + bj * HALF + n * 16); acc[ai][bj][m][n] = bs + (acc[ai][bj][m][n] - sr.x) * sr.y; }
                asm volatile("" : "+v"(acc[ai][0][m][0]), "+v"(acc[ai][0][m][1]), "+v"(acc[ai][1][m][0]), "+v"(acc[ai][1][m][1]));
                if (m & 1) asm volatile("" ::: "memory"); }
        const bool bad1 = bad;
        bad = st2.run(acc, u, wr, wc, fr, fq, lds, wid, lane) || bad;
#pragma unroll
        for (int ai = 0; ai < 2; ++ai)
#pragma unroll
            for (int m = 0; m < 4; ++m) { const int r = ai * HALF + wr * 64 + m * 16 + fr; const f32x2v sr = S[r]; const size_t off = (size_t)(u.pm * BM + r) * ldc + col0;
#pragma unroll
                for (int bj = 0; bj < 2; ++bj)
#pragma unroll
                    for (int n = 0; n < 2; ++n) { const f32x4 x1 = acc[ai][bj][m][n]; *(f32x4*)(out + off + bj * HALF + n * 16) = bad1 ? (f32x4){qnan, qnan, qnan, qnan} : x1;
                        const f32x4 o = (x1 - sr.x) * sr.y; u32x2v w; w.x = cvt_pk_bf16(o[0], o[1]); w.y = cvt_pk_bf16(o[2], o[3]);
                        if (bad) { w.x = 0x7fc07fc0u; w.y = 0x7fc07fc0u; } *(u32x2v*)(xn + off + bj * HALF + n * 16) = w; }
                asm volatile("" ::: "memory"); }
    }
};

template <class Epi, class Sched, bool ALIGN_EPI = false, bool SP2 = false>
__device__ __forceinline__ void gemm_phase(PG8_LAS unsigned char* lds, const Gemm g, const Sched& S, const Epi& E) {
    const int tid = threadIdx.x, wid = __builtin_amdgcn_readfirstlane(tid >> 6), lane = tid & 63, wr = wid >> 2, wc = wid & 3, fr = lane & 15, fq = lane >> 4;
    const int K = g.K, nt = K / BK;
    unsigned voffA[2], voffB[2];
#pragma unroll
    for (int i = 0; i < 2; ++i) { int R, C; stage_rc(tid * 16 + i * 8192, R, C); const int Rb = Epi::PERM ? ((R & ~31) + perm32(R & 31)) : R;
        voffA[i] = (unsigned)(R * K + C) * 2u; voffB[i] = (unsigned)(Rb * K + C) * 2u; }
    const size_t kstep = (size_t)(BK * 2);
    const size_t hstep = (size_t)HALF * K * 2;
    const size_t tstep = 2 * hstep;
    const unsigned ldsw = (unsigned)wid * 1024u;
    const int aoff = lds_byte(wr * 64 + fr, fq * 8), boff = lds_byte(wc * 32 + fr, fq * 8);
#define PG8_SA(b, h) (((b) * 2 + (h)) * HTB)
#define PG8_SB(b, h) ((4 + (b) * 2 + (h)) * HTB)
#define PG8_STAGE(bufoff, gbase, voff) do { _Pragma("unroll") for (int _i = 0; _i < 2; ++_i) \
        __builtin_amdgcn_global_load_lds((const unsigned*)((const char*)(gbase) + (voff)[_i]), (PG8_LAS unsigned*)(lds + (bufoff) + ldsw + _i * 8192), 16, 0, 0); } while (0)
#define PG8_LDA(dst, b, h) do { _Pragma("unroll") for (int m = 0; m < 4; ++m) _Pragma("unroll") for (int k = 0; k < 2; ++k) dst[m][k] = *(const PG8_LAS bf16x8*)(lds + PG8_SA(b, h) + aoff + m * 2048 + k * 1024); } while (0)
#define PG8_LDB(dst, b, h) do { _Pragma("unroll") for (int n = 0; n < 2; ++n) _Pragma("unroll") for (int k = 0; k < 2; ++k) dst[n][k] = *(const PG8_LAS bf16x8*)(lds + PG8_SB(b, h) + boff + n * 2048 + k * 1024); } while (0)
#define PG8_MMA(ai, bj, At, Bt) do { __builtin_amdgcn_s_setprio(1); _Pragma("unroll") for (int m = 0; m < 4; ++m) _Pragma("unroll") for (int n = 0; n < 2; ++n) _Pragma("unroll") for (int k = 0; k < 2; ++k) \
        acc[ai][bj][m][n] = __builtin_amdgcn_mfma_f32_16x16x32_bf16(Bt[n][k], At[m][k], acc[ai][bj][m][n], 0, 0, 0); __builtin_amdgcn_s_setprio(0); } while (0)
#define PG8_WAIT_V(n) asm volatile("s_waitcnt vmcnt(" #n ")" ::: "memory")
#define PG8_WAIT_L(n) asm volatile("s_waitcnt lgkmcnt(" #n ")" ::: "memory")
#define PG8_BAR __builtin_amdgcn_s_barrier()
#define PG8_SCHED __builtin_amdgcn_sched_barrier(0)
    Unit cur, nxt; int ui = 0;
    if (!S.next(0, cur)) return;
    f32x4 acc[2][2][4][2];
#pragma unroll
    for (int a = 0; a < 2; ++a)
#pragma unroll
        for (int b = 0; b < 2; ++b)
#pragma unroll
            for (int m = 0; m < 4; ++m)
#pragma unroll
                for (int n = 0; n < 2; ++n) acc[a][b][m][n] = (f32x4){0.f, 0.f, 0.f, 0.f};
    bf16x8 At[4][2], B0[2][2], B1[2][2];
    const char* cA = (const char*)g.A + (size_t)cur.pm * tstep; const char* cB = (const char*)g.Bt + (size_t)cur.pn * tstep;
    S.a_ready(cur);
    if constexpr (SP2) {
        PG8_STAGE(PG8_SB(0, 0), cB, voffB); PG8_STAGE(PG8_SB(0, 1), cB + hstep, voffB); PG8_STAGE(PG8_SA(0, 0), cA, voffA); PG8_STAGE(PG8_SA(0, 1), cA + hstep, voffA);
        if (wr == 1) PG8_BAR;
        PG8_WAIT_V(2); PG8_BAR;
        PG8_STAGE(PG8_SB(1, 0), cB + kstep, voffB); PG8_STAGE(PG8_SA(1, 0), cA + kstep, voffA); PG8_STAGE(PG8_SB(1, 1), cB + hstep + kstep, voffB);
        PG8_WAIT_V(6); PG8_BAR;
    } else {
        PG8_STAGE(PG8_SB(0, 0), cB, voffB); PG8_STAGE(PG8_SA(0, 0), cA, voffA); PG8_STAGE(PG8_SB(0, 1), cB + hstep, voffB); PG8_STAGE(PG8_SA(0, 1), cA + hstep, voffA);
        if (wr == 1) PG8_BAR;
        PG8_WAIT_V(4); PG8_BAR;
        PG8_STAGE(PG8_SB(1, 0), cB + kstep, voffB); PG8_STAGE(PG8_SA(1, 0), cA + kstep, voffA); PG8_STAGE(PG8_SB(1, 1), cB + hstep + kstep, voffB);
        PG8_WAIT_V(6); PG8_BAR;
    }
    for (;;) {
        const bool has_next = S.next(ui + 1, nxt);
        const char* nA = has_next ? (const char*)g.A + (size_t)nxt.pm * tstep : cA; const char* nB = has_next ? (const char*)g.Bt + (size_t)nxt.pn * tstep : cB;
        for (int t = 0; t < nt; t += 2) {
            const bool last = (t == nt - 2);
            const char* a1 = cA + (size_t)(t + 1) * kstep;
            const char* a2 = last ? nA : cA + (size_t)(t + 2) * kstep; const char* b2 = last ? nB : cB + (size_t)(t + 2) * kstep;
            const char* a3 = a2 + kstep; const char* b3 = b2 + kstep;
            if (last && has_next) S.a_ready(nxt);
            if constexpr (SP2) {
            PG8_LDB(B0, 0, 0); PG8_LDB(B1, 0, 1); PG8_SCHED; PG8_LDA(At, 0, 0); PG8_STAGE(PG8_SA(1, 1), a1 + hstep, voffA);
            PG8_WAIT_V(8); PG8_WAIT_L(0); PG8_BAR; PG8_MMA(0, 0, At, B0); PG8_MMA(0, 1, At, B1); PG8_BAR; PG8_SCHED;
            PG8_LDA(At, 0, 1); PG8_STAGE(PG8_SB(0, 0), b2, voffB); PG8_STAGE(PG8_SB(0, 1), b2 + hstep, voffB); PG8_STAGE(PG8_SA(0, 0), a2, voffA);
            PG8_WAIT_V(8); PG8_WAIT_L(0); PG8_BAR; PG8_MMA(1, 0, At, B0); PG8_MMA(1, 1, At, B1); PG8_BAR; PG8_SCHED;
            PG8_LDB(B0, 1, 0); PG8_LDB(B1, 1, 1); PG8_SCHED; PG8_LDA(At, 1, 0); PG8_STAGE(PG8_SA(0, 1), a2 + hstep, voffA);
            PG8_WAIT_V(8); PG8_WAIT_L(0); PG8_BAR; PG8_MMA(0, 0, At, B0); PG8_MMA(0, 1, At, B1); PG8_BAR; PG8_SCHED;
            PG8_LDA(At, 1, 1); PG8_STAGE(PG8_SB(1, 0), b3, voffB); PG8_STAGE(PG8_SB(1, 1), b3 + hstep, voffB); PG8_STAGE(PG8_SA(1, 0), a3, voffA);
            PG8_WAIT_V(8); PG8_WAIT_L(0); PG8_BAR; PG8_MMA(1, 0, At, B0); PG8_MMA(1, 1, At, B1); PG8_BAR; PG8_SCHED;
            } else {
            PG8_LDB(B0, 0, 0); PG8_SCHED; PG8_LDA(At, 0, 0); PG8_STAGE(PG8_SA(1, 1), a1 + hstep, voffA);
            PG8_WAIT_L(8); PG8_BAR; PG8_WAIT_L(0); PG8_MMA(0, 0, At, B0); PG8_BAR; PG8_SCHED;
            PG8_LDB(B1, 0, 1); PG8_STAGE(PG8_SB(0, 0), b2, voffB);
            PG8_BAR; PG8_WAIT_L(0); PG8_MMA(0, 1, At, B1); PG8_BAR;
            PG8_LDA(At, 0, 1); PG8_STAGE(PG8_SA(0, 0), a2, voffA);
            PG8_BAR; PG8_WAIT_L(0); PG8_MMA(1, 0, At, B0); PG8_BAR; PG8_SCHED;
            PG8_STAGE(PG8_SB(0, 1), b2 + hstep, voffB);
            PG8_WAIT_V(6); PG8_BAR; PG8_MMA(1, 1, At, B1); PG8_BAR;
            PG8_LDB(B0, 1, 0); PG8_SCHED; PG8_LDA(At, 1, 0); PG8_STAGE(PG8_SA(0, 1), a2 + hstep, voffA);
            PG8_WAIT_L(8); PG8_BAR; PG8_WAIT_L(0); PG8_MMA(0, 0, At, B0); PG8_BAR; PG8_SCHED;
            PG8_LDB(B1, 1, 1); PG8_STAGE(PG8_SB(1, 0), b3, voffB);
            PG8_BAR; PG8_WAIT_L(0); PG8_MMA(0, 1, At, B1); PG8_BAR;
            PG8_LDA(At, 1, 1); PG8_STAGE(PG8_SA(1, 0), a3, voffA);
            PG8_BAR; PG8_WAIT_L(0); PG8_MMA(1, 0, At, B0); PG8_BAR; PG8_SCHED;
            PG8_STAGE(PG8_SB(1, 1), b3 + hstep, voffB);
            PG8_WAIT_V(6); PG8_BAR; PG8_MMA(1, 1, At, B1); PG8_BAR;
            }
        }
        if constexpr (ALIGN_EPI) { if (wr == 0) PG8_BAR; }
        if constexpr (!Epi::AFTER_DRAIN) { E(acc, cur, wr, wc, fr, fq); S.done(cur); }
        if (!has_next) break;
#pragma unroll
        for (int a = 0; a < 2; ++a)
#pragma unroll
            for (int b = 0; b < 2; ++b)
#pragma unroll
                for (int m = 0; m < 4; ++m)
#pragma unroll
                    for (int n = 0; n < 2; ++n) acc[a][b][m][n] = (f32x4){0.f, 0.f, 0.f, 0.f};
        cur = nxt; cA = nA; cB = nB; ++ui;
        if constexpr (ALIGN_EPI) { if (wr == 1) PG8_BAR; }
    }
    PG8_WAIT_V(0);
    if constexpr (!ALIGN_EPI) { if (wr == 0) PG8_BAR; }
    PG8_BAR;
    if constexpr (Epi::AFTER_DRAIN) { E.fused(acc, cur, wr, wc, fr, fq, lds, wid, lane); S.done(cur); }
#undef PG8_SA
#undef PG8_SB
#undef PG8_STAGE
#undef PG8_LDA
#undef PG8_LDB
#undef PG8_MMA
#undef PG8_WAIT_V
#undef PG8_WAIT_L
#undef PG8_BAR
#undef PG8_SCHED
}
}
#ifndef PG8_SP2
#define PG8_SP2 true
#endif
#ifndef PG8_ALIGN
#define PG8_ALIGN true
#endif
namespace pg8 {
__device__ __forceinline__ float gelu_tanh(float x) {
    const float GC1 = -2.3022082f, GC2 = -0.10294324f;
    const float e = __builtin_amdgcn_exp2f(x * (GC1 + GC2 * x * x));
    return x * __builtin_amdgcn_rcpf(1.0f + e);
}
struct EpiProj {
    static constexpr bool PERM = true, AFTER_DRAIN = false;
    bf16_t* O; int ldc; float qscale; bf16_t* KV;
    __device__ __forceinline__ void operator()(const f32x4 (&acc)[2][2][4][2], const Unit& u, int wr, int wc, int fr, int fq) const {
        const int row0 = u.pm * BM + wr * 64 + fr, col0 = u.pn * BM + wc * 32 + 8 * fq;
        const float sc = (u.pn >= 2 && u.pn < 5) ? qscale : 1.f;
#pragma unroll
        for (int ai = 0; ai < 2; ++ai)
#pragma unroll
            for (int m = 0; m < 4; ++m) { const int row = row0 + ai * HALF + m * 16;
#pragma unroll
                for (int bj = 0; bj < 2; ++bj) { const f32x4 v0 = acc[ai][bj][m][0] * sc, v1 = acc[ai][bj][m][1] * sc;
                    u32x4 w; w.x = cvt_pk_bf16(v0[0], v0[1]); w.y = cvt_pk_bf16(v0[2], v0[3]); w.z = cvt_pk_bf16(v1[0], v1[1]); w.w = cvt_pk_bf16(v1[2], v1[3]);
                    bf16_t* dst;
                    if (u.pn < 5) dst = O + (size_t)row * ldc + col0 + bj * HALF;
                    else { const int kc = col0 + bj * HALF - 1280, isv = kc >= 768 ? 1 : 0, hc = kc - 768 * isv;
                        dst = KV + ((size_t)((row >> 11) * 12 + (hc >> 6)) * 2048 + (row & 2047)) * 128 + isv * 64 + (hc & 63); }
                    *(u32x4*)dst = w; } }
    }
};
struct EpiF32 {
    static constexpr bool PERM = false, AFTER_DRAIN = false;
    float* out; int ldc;
    __device__ __forceinline__ void operator()(const f32x4 (&acc)[2][2][4][2], const Unit& u, int wr, int wc, int fr, int fq) const {
        const int col0 = u.pn * BM + wc * 32 + 4 * fq;
#pragma unroll
        for (int ai = 0; ai < 2; ++ai)
#pragma unroll
            for (int m = 0; m < 4; ++m) { const int r = ai * HALF + wr * 64 + m * 16 + fr; const size_t off = (size_t)(u.pm * BM + r) * ldc + col0;
#pragma unroll
                for (int bj = 0; bj < 2; ++bj)
#pragma unroll
                    for (int n = 0; n < 2; ++n) *(f32x4*)(out + off + bj * HALF + n * 16) = acc[ai][bj][m][n]; }
    }
};
__device__ __forceinline__ float dpp_ror1(float v) { return __builtin_bit_cast(float, __builtin_amdgcn_update_dpp(0, __builtin_bit_cast(int, v), 0x121, 0xf, 0xf, true)); }
__device__ __forceinline__ float dpp_ror2(float v) { return __builtin_bit_cast(float, __builtin_amdgcn_update_dpp(0, __builtin_bit_cast(int, v), 0x122, 0xf, 0xf, true)); }
__device__ __forceinline__ float dpp_shr1(float old, float v) { return __builtin_bit_cast(float, __builtin_amdgcn_update_dpp(__builtin_bit_cast(int, old), __builtin_bit_cast(int, v), 0x111, 0xf, 0xf, false)); }
__device__ __forceinline__ float dpp_shr2(float old, float v) { return __builtin_bit_cast(float, __builtin_amdgcn_update_dpp(__builtin_bit_cast(int, old), __builtin_bit_cast(int, v), 0x112, 0xf, 0xf, false)); }
struct EpiGateUp {
    static constexpr bool PERM = true, AFTER_DRAIN = false;
    bf16_t* ACT; int ldc; const float* cw; const float* cb; float* FG; float* FU; float* LG;
    __device__ __forceinline__ void operator()(const f32x4 (&acc)[2][2][4][2], const Unit& u, int wr, int wc, int fr, int fq) const {
        const int gc0 = u.pn * 128 + wc * 32 + 8 * fq;
        f32x4 w0[2], w1[2], w2[2], bb[2];
#pragma unroll
        for (int n = 0; n < 2; ++n) { w0[n] = *(const f32x4*)(cw + gc0 + 4 * n); w1[n] = *(const f32x4*)(cw + ldc + gc0 + 4 * n); w2[n] = *(const f32x4*)(cw + 2 * ldc + gc0 + 4 * n); bb[n] = *(const f32x4*)(cb + gc0 + 4 * n); }
#pragma unroll
        for (int ai = 0; ai < 2; ++ai) {
            const int grp = u.pm * 4 + ai * 2 + wr;
            f32x4 prev[2]; prev[0] = (f32x4){0.f, 0.f, 0.f, 0.f}; prev[1] = prev[0];
#pragma unroll
            for (int m = 0; m < 4; ++m) {
                float a[8];
#pragma unroll
                for (int n = 0; n < 2; ++n) { const f32x4 G = acc[ai][0][m][n], U = acc[ai][1][m][n];
#pragma unroll
                    for (int j = 0; j < 4; ++j) { const float p1 = dpp_shr1(dpp_ror1(prev[n][j]), G[j]), p2 = dpp_shr2(dpp_ror2(prev[n][j]), G[j]);
                        const float cv = bb[n][j] + w2[n][j] * G[j] + w1[n][j] * p1 + w0[n][j] * p2; a[4 * n + j] = gelu_tanh(cv) * U[j]; }
                    if (m == 0 && fr < 2) { *(f32x4*)(FG + (size_t)(grp * 2 + fr) * ldc + gc0 + 4 * n) = G; *(f32x4*)(FU + (size_t)(grp * 2 + fr) * ldc + gc0 + 4 * n) = U; }
                    if (m == 3 && fr >= 14) *(f32x4*)(LG + (size_t)(grp * 2 + fr - 14) * ldc + gc0 + 4 * n) = G;
                    prev[n] = G; }
                u32x4 w; w.x = cvt_pk_bf16(a[0], a[1]); w.y = cvt_pk_bf16(a[2], a[3]); w.z = cvt_pk_bf16(a[4], a[5]); w.w = cvt_pk_bf16(a[6], a[7]);
                *(u32x4*)(ACT + (size_t)(u.pm * BM + ai * HALF + wr * 64 + m * 16 + fr) * ldc + gc0) = w;
            }
        }
    }
};
}
namespace mixer {
#define MX_LAS __attribute__((address_space(3)))
using bf16x8 = __attribute__((ext_vector_type(8))) short;
using s16x4 = __attribute__((ext_vector_type(4))) short;
using f32x16 = __attribute__((ext_vector_type(16))) float;
using f32x4 = __attribute__((ext_vector_type(4))) float;
using u32x4 = __attribute__((ext_vector_type(4))) unsigned;
using u32x2 = __attribute__((ext_vector_type(2))) unsigned;
typedef unsigned short bf16_t;
typedef MX_LAS const char* lds_cptr;
typedef short v4i16_t __attribute__((ext_vector_type(4)));
constexpr int SEQ = 2048, NH = 12, PP = 1280, MP = 1024, KP = 128;
constexpr int COL_U = 0, COL_V = 256, COL_Q = 512, MIX_B = 256;
constexpr float LOG2E = 1.4426950408889634f, C2 = 0.125f * LOG2E;
constexpr int SLOT = 16384, KOFF = 0, VOFF = 8192, LUTN = 256;
__device__ __forceinline__ float max3f(float a, float b, float c) { return __builtin_fmaxf(__builtin_fmaxf(a, b), c); }
typedef float f32x2_t __attribute__((ext_vector_type(2))); typedef __bf16 bf16x2_t __attribute__((ext_vector_type(2)));
__device__ __forceinline__ unsigned cvtpk(float lo, float hi) { f32x2_t v = {lo, hi}; bf16x2_t b = __builtin_convertvector(v, bf16x2_t); return __builtin_bit_cast(unsigned, b); }
__device__ __forceinline__ float bf2f(unsigned short h) { return __builtin_bit_cast(float, (unsigned)h << 16); }
__device__ __forceinline__ s16x4 vtr(lds_cptr p) { return __builtin_bit_cast(s16x4, __builtin_amdgcn_ds_read_tr16_b64_v4i16((MX_LAS v4i16_t*)p)); }
__device__ __forceinline__ float gelu_tanh(float x) {
    const float e = __builtin_amdgcn_exp2f(x * (-2.3022082f + -0.10294324f * x * x));
    return x * __builtin_amdgcn_rcpf(1.0f + e);
}
__device__ __forceinline__ void dma_tile1(MX_LAS char* slot, const bf16_t* kp, const bf16_t* vp, long vstep) {
#pragma unroll
    for (int c = 0; c < 8; ++c) __builtin_amdgcn_global_load_lds((const unsigned*)(kp + 8 * c), (MX_LAS unsigned*)(slot + KOFF + c * 1024), 16, 0, 0);
#pragma unroll
    for (int dh = 0; dh < 2; ++dh)
#pragma unroll
        for (int g = 0; g < 4; ++g) __builtin_amdgcn_global_load_lds((const unsigned*)(vp + g * vstep + dh * 32), (MX_LAS unsigned*)(slot + VOFF + (dh * 4 + g) * 1024), 16, 0, 0);
}
__device__ __forceinline__ void block_tile(f32x16& o0, f32x16& o1, float& m, float& l, const bf16x8 (&qr)[4], lds_cptr kl, lds_cptr vl, const MX_LAS float* lut) {
    f32x16 s0, s1;
#pragma unroll
    for (int r = 0; r < 16; ++r) { s0[r] = lut[(r & 3) + 8 * (r >> 2)]; s1[r] = lut[32 + (r & 3) + 8 * (r >> 2)]; }
#pragma unroll
    for (int d0 = 0; d0 < 4; ++d0) {
        const bf16x8 b0 = *(const MX_LAS bf16x8*)(kl + d0 * 2048), b1 = *(const MX_LAS bf16x8*)(kl + d0 * 2048 + 512);
        s0 = __builtin_amdgcn_mfma_f32_32x32x16_bf16(b0, qr[d0], s0, 0, 0, 0);
        s1 = __builtin_amdgcn_mfma_f32_32x32x16_bf16(b1, qr[d0], s1, 0, 0, 0);
    }
    float a = max3f(s0[0], s0[1], s1[0]), b = max3f(s0[2], s0[3], s1[1]); a = max3f(a, s1[2], s1[3]);
#pragma unroll
    for (int r = 4; r < 16; r += 4) { a = max3f(a, s0[r], s0[r + 1]); b = max3f(b, s0[r + 2], s0[r + 3]); a = max3f(a, s1[r], s1[r + 1]); b = max3f(b, s1[r + 2], s1[r + 3]); }
    float rm = __builtin_fmaxf(a, b);
    { auto rr = __builtin_amdgcn_permlane32_swap(__float_as_uint(rm), __float_as_uint(rm), false, false); rm = __builtin_fmaxf(__uint_as_float(rr[0]), __uint_as_float(rr[1])); }
    const float mn = __builtin_fmaxf(m, rm), alpha = __builtin_amdgcn_exp2f(m - mn); m = mn;
    float ps = 0.f;
#pragma unroll
    for (int r = 0; r < 16; ++r) { s0[r] = __builtin_amdgcn_exp2f(s0[r] - mn); s1[r] = __builtin_amdgcn_exp2f(s1[r] - mn); ps += s0[r] + s1[r]; }
    l = l * alpha + ps;
#pragma unroll
    for (int r = 0; r < 16; ++r) { o0[r] *= alpha; o1[r] *= alpha; }
    u32x4 pw[4];
#pragma unroll
    for (int i = 0; i < 4; ++i) { pw[0][i] = cvtpk(s0[2 * i], s0[2 * i + 1]); pw[1][i] = cvtpk(s0[8 + 2 * i], s0[8 + 2 * i + 1]); pw[2][i] = cvtpk(s1[2 * i], s1[2 * i + 1]); pw[3][i] = cvtpk(s1[8 + 2 * i], s1[8 + 2 * i + 1]); }
#pragma unroll
    for (int ks = 0; ks < 4; ++ks) {
        const s16x4 lo0 = vtr(vl + ks * 1024), hi0 = vtr(vl + ks * 1024 + 512), lo1 = vtr(vl + 4096 + ks * 1024), hi1 = vtr(vl + 4096 + ks * 1024 + 512);
        const bf16x8 v0 = (bf16x8){lo0[0], lo0[1], lo0[2], lo0[3], hi0[0], hi0[1], hi0[2], hi0[3]}, v1 = (bf16x8){lo1[0], lo1[1], lo1[2], lo1[3], hi1[0], hi1[1], hi1[2], hi1[3]};
        const bf16x8 p = __builtin_bit_cast(bf16x8, pw[ks]);
        o0 = __builtin_amdgcn_mfma_f32_32x32x16_bf16(v0, p, o0, 0, 0, 0);
        o1 = __builtin_amdgcn_mfma_f32_32x32x16_bf16(v1, p, o1, 0, 0, 0);
    }
}
__device__ __forceinline__ void dma_tile(MX_LAS char* slot, const bf16_t* kp, const bf16_t* vp, long vstep) {
    dma_tile1(slot, kp, vp, vstep);
#ifdef PROBE_DMA2
    asm volatile("s_waitcnt vmcnt(0)" ::: "memory"); dma_tile1(slot, kp, vp, vstep);
#endif
}
struct Tensors { const bf16_t* PROJ; const bf16_t* KV; bf16_t* MIX; float* LSE; const float* rel_bias; const bf16_t* WSP; const float* ln_g; const float* ln_b; const float* sp_b; };
#define MX_WAIT_V0() asm volatile("s_waitcnt vmcnt(0)" ::: "memory")
#define MX_WAIT_L0() asm volatile("s_waitcnt lgkmcnt(0)" ::: "memory")

__device__ __forceinline__ void attn_unit(const Tensors& T, int b, int h, int n, MX_LAS char* lds, MX_LAS float* LUT, int wave, int lane) {
    const int r32 = lane & 31, hi = lane >> 5, tid = threadIdx.x;
    __syncthreads();
    for (int i = tid; i < 3 * LUTN; i += 512) {
        const int seg = i >> 8, x = i & 255, rel = 192 - x; float v = -INFINITY;
        if (rel >= 0 && rel <= 128) { const int dist = rel << (2 * seg); int bk = dist;
            if (dist >= 16) { bk = 16 + (int)(__log2f((float)dist * 0.0625f) * (16.0f / 7.0f)); bk = bk > 31 ? 31 : bk; }
            v = T.rel_bias[bk * NH + h] * LOG2E; }
        LUT[i] = v;
    }
    __syncthreads();
    MX_LAS char* slot = lds + wave * SLOT;
    const lds_cptr kl = (lds_cptr)slot + KOFF + hi * 1024 + r32 * 16;
    const lds_cptr vl = (lds_cptr)slot + VOFF + ((lane >> 4) & 1) * 32 + (lane & 3) * 8 + (4 * hi + ((lane & 15) >> 2)) * 64;
    const long rowb = (long)b * SEQ; const int P0 = 512 * n;
    const bf16_t* Kh = T.KV + (long)(b * NH + h) * SEQ * KP; const bf16_t* Vh = Kh + 64; const bf16_t* Qh = T.PROJ + rowb * PP + COL_Q + 64 * h;
    bf16_t* Mh = T.MIX + rowb * MP + MIX_B + 64 * h; float* Lh = T.LSE + rowb * NH + h;
    {
        bf16x8 qa[4], qb[4];
        const int pa = P0 + 64 * wave + r32, pb = pa + 32;
#pragma unroll
        for (int d0 = 0; d0 < 4; ++d0) { qa[d0] = *(const bf16x8*)(Qh + (long)pa * PP + d0 * 16 + hi * 8); qb[d0] = *(const bf16x8*)(Qh + (long)pb * PP + d0 * 16 + hi * 8); }
        f32x16 oa0 = {}, oa1 = {}, ob0 = {}, ob1 = {}; float ma = -1e30f, la = 0.f, mb = -1e30f, lb = 0.f;
#pragma unroll 1
        for (int a = 0; a < 3; ++a) {
            const int k0 = P0 + 64 * wave - 128 + 64 * a; if (k0 < 0) continue;
            MX_WAIT_L0();
            dma_tile(slot, Kh + (long)(k0 + lane) * KP, Vh + (long)(k0 + (lane >> 2)) * KP + (lane & 3) * 8, 16L * KP);
            MX_WAIT_V0();
            const int xa = 64 + 64 * a - r32 + 4 * hi, xb = xa - 32;
            block_tile(oa0, oa1, ma, la, qa, kl, vl, LUT + xa);
            __builtin_amdgcn_sched_barrier(0);
            block_tile(ob0, ob1, mb, lb, qb, kl, vl, LUT + xb);
        }
#define MX_EPI_A(o0_, o1_, m_, l_, p_) do { float lt = l_; { auto rr = __builtin_amdgcn_permlane32_swap(__float_as_uint(lt), __float_as_uint(lt), false, false); lt = __uint_as_float(rr[0]) + __uint_as_float(rr[1]); } \
            const float il = __builtin_amdgcn_rcpf(lt); bf16_t* mrow = Mh + (long)(p_) * MP + 4 * hi; \
            _Pragma("unroll") for (int rq = 0; rq < 4; ++rq) { u32x2 w0, w1; w0.x = cvtpk(o0_[4 * rq] * il, o0_[4 * rq + 1] * il); w0.y = cvtpk(o0_[4 * rq + 2] * il, o0_[4 * rq + 3] * il); \
                w1.x = cvtpk(o1_[4 * rq] * il, o1_[4 * rq + 1] * il); w1.y = cvtpk(o1_[4 * rq + 2] * il, o1_[4 * rq + 3] * il); *(u32x2*)(mrow + 8 * rq) = w0; *(u32x2*)(mrow + 32 + 8 * rq) = w1; } \
            if (hi == 0) Lh[(long)(p_) * NH] = m_ + __log2f(lt); } while (0)
        MX_EPI_A(oa0, oa1, ma, la, pa);
        MX_EPI_A(ob0, ob1, mb, lb, pb);
#undef MX_EPI_A
    }
    MX_WAIT_V0(); MX_WAIT_L0();
    __syncthreads();
    {
        const int ra = wave, rb = wave + 8, c4 = wave & 3;
        const int pa = P0 + 16 * r32 + ra, pb = P0 + 16 * r32 + rb;
        bf16x8 qa[4], qb[4];
#pragma unroll
        for (int d0 = 0; d0 < 4; ++d0) { qa[d0] = *(const bf16x8*)(Qh + (long)pa * PP + d0 * 16 + hi * 8); qb[d0] = *(const bf16x8*)(Qh + (long)pb * PP + d0 * 16 + hi * 8); }
        f32x16 oa0 = {}, oa1 = {}, ob0 = {}, ob1 = {}; float ma = -1e30f, la = 0.f, mb = -1e30f, lb = 0.f;
#pragma unroll 1
        for (int a = 0; a < 4; ++a) {
            const int jk0 = 128 * (n - 1) + 64 * a; if (jk0 < 0) continue;
            MX_WAIT_L0();
            dma_tile(slot, Kh + (long)(4 * (jk0 + lane) + c4) * KP, Vh + (long)(4 * (jk0 + (lane >> 2)) + c4) * KP + (lane & 3) * 8, 64L * KP);
            MX_WAIT_V0();
            int xa = 64 + 64 * a - (ra >> 2) - 4 * r32 + 4 * hi, xb = 64 + 64 * a - (rb >> 2) - 4 * r32 + 4 * hi;
            xa = xa < 0 ? 0 : (xa > 196 ? 196 : xa); xb = xb < 0 ? 0 : (xb > 196 ? 196 : xb);
            block_tile(oa0, oa1, ma, la, qa, kl, vl, LUT + LUTN + xa);
            __builtin_amdgcn_sched_barrier(0);
            block_tile(ob0, ob1, mb, lb, qb, kl, vl, LUT + LUTN + xb);
        }
#pragma unroll 1
        for (int a = 0; a <= (n >> 1); ++a) {
            const int x3 = 192 - 32 * n + 64 * a - r32 + 4 * hi;
            MX_WAIT_L0();
            dma_tile(slot, Kh + (long)(16 * (64 * a + lane) + ra) * KP, Vh + (long)(16 * (64 * a + (lane >> 2)) + ra) * KP + (lane & 3) * 8, 256L * KP);
            MX_WAIT_V0();
            block_tile(oa0, oa1, ma, la, qa, kl, vl, LUT + 2 * LUTN + x3);
            MX_WAIT_L0();
            dma_tile(slot, Kh + (long)(16 * (64 * a + lane) + rb) * KP, Vh + (long)(16 * (64 * a + (lane >> 2)) + rb) * KP + (lane & 3) * 8, 256L * KP);
            MX_WAIT_V0();
            block_tile(ob0, ob1, mb, lb, qb, kl, vl, LUT + 2 * LUTN + x3);
        }
#define MX_EPI_B(o0_, o1_, m_, l_, p_) do { float lt = l_; { auto rr = __builtin_amdgcn_permlane32_swap(__float_as_uint(lt), __float_as_uint(lt), false, false); lt = __uint_as_float(rr[0]) + __uint_as_float(rr[1]); } \
            const float lse2 = m_ + __log2f(lt), lse1 = Lh[(long)(p_) * NH], mm = __builtin_fmaxf(lse1, lse2), e1 = __builtin_amdgcn_exp2f(lse1 - mm), e2 = __builtin_amdgcn_exp2f(lse2 - mm); \
            const float id = __builtin_amdgcn_rcpf(e1 + e2), w1 = e1 * id, w2 = e2 * id * __builtin_amdgcn_rcpf(lt); bf16_t* mrow = Mh + (long)(p_) * MP + 4 * hi; \
            _Pragma("unroll") for (int rq = 0; rq < 4; ++rq) { const u32x2 a0 = *(const u32x2*)(mrow + 8 * rq), a1 = *(const u32x2*)(mrow + 32 + 8 * rq); u32x2 w0, w1_; \
                w0.x = cvtpk(w1 * bf2f(a0.x & 0xffff) + w2 * o0_[4 * rq], w1 * bf2f(a0.x >> 16) + w2 * o0_[4 * rq + 1]); w0.y = cvtpk(w1 * bf2f(a0.y & 0xffff) + w2 * o0_[4 * rq + 2], w1 * bf2f(a0.y >> 16) + w2 * o0_[4 * rq + 3]); \
                w1_.x = cvtpk(w1 * bf2f(a1.x & 0xffff) + w2 * o1_[4 * rq], w1 * bf2f(a1.x >> 16) + w2 * o1_[4 * rq + 1]); w1_.y = cvtpk(w1 * bf2f(a1.y & 0xffff) + w2 * o1_[4 * rq + 2], w1 * bf2f(a1.y >> 16) + w2 * o1_[4 * rq + 3]); \
                *(u32x2*)(mrow + 8 * rq) = w0; *(u32x2*)(mrow + 32 + 8 * rq) = w1_; } } while (0)
        MX_EPI_B(oa0, oa1, ma, la, pa);
        MX_EPI_B(ob0, ob1, mb, lb, pb);
#undef MX_EPI_B
    }
    MX_WAIT_L0();
}

__device__ __forceinline__ void gmlp_unit(const Tensors& T, int b, int ch, int g, MX_LAS char* slot, int lane) {
    const int r32 = lane & 31, hi = lane >> 5;
    const long t0 = (long)b * SEQ + 128 * ch;
    const float* lg = T.ln_g + 64 * g; const float* lb = T.ln_b + 64 * g;
    MX_WAIT_L0();
#pragma unroll 1
    for (int tk = 0; tk < 2; ++tk) {
        const int s = lane + 64 * tk; const bf16_t* vrow = T.PROJ + (t0 + s) * PP + COL_V + 64 * g;
        float x[64]; float sum = 0.f;
#pragma unroll
        for (int c = 0; c < 8; ++c) { const u32x4 w = *(const u32x4*)(vrow + 8 * c);
#pragma unroll
            for (int j = 0; j < 4; ++j) { const float lo = gelu_tanh(bf2f(w[j] & 0xffff)), hh = gelu_tanh(bf2f(w[j] >> 16)); x[8 * c + 2 * j] = lo; x[8 * c + 2 * j + 1] = hh; sum += lo + hh; } }
        const float mu = sum * (1.f / 64.f); float q = 0.f;
#pragma unroll
        for (int d = 0; d < 64; ++d) { x[d] -= mu; q += x[d] * x[d]; }
        const float rstd = __builtin_amdgcn_rsqf(q * (1.f / 64.f) + 1e-6f);
#pragma unroll
        for (int d = 0; d < 64; ++d) { const float vn = x[d] * rstd * lg[d] + lb[d];
            *(MX_LAS unsigned short*)(slot + d * 256 + ((((s >> 3) ^ (d & 15))) << 4) + (s & 7) * 2) = (unsigned short)(cvtpk(vn, vn) & 0xffff); }
    }
    MX_WAIT_L0();
    const bf16_t* W = T.WSP + (long)g * 128 * 128;
#pragma unroll 1
    for (int tt = 0; tt < 4; ++tt) {
        f32x16 z0 = {}, z1 = {};
        const bf16_t* wrow = W + (32 * tt + r32) * 128 + 8 * hi;
        for (int ks = 0; ks <= 2 * tt + 1; ++ks) {
            const bf16x8 bw = *(const bf16x8*)(wrow + 16 * ks);
            const bf16x8 a0 = *(const MX_LAS bf16x8*)(slot + r32 * 256 + (((2 * ks + hi) ^ (r32 & 15)) << 4));
            const bf16x8 a1 = *(const MX_LAS bf16x8*)(slot + (32 + r32) * 256 + (((2 * ks + hi) ^ (r32 & 15)) << 4));
            z0 = __builtin_amdgcn_mfma_f32_32x32x16_bf16(a0, bw, z0, 0, 0, 0);
            z1 = __builtin_amdgcn_mfma_f32_32x32x16_bf16(a1, bw, z1, 0, 0, 0);
        }
        const int t = 32 * tt + r32; const float bs = T.sp_b[g * 128 + t];
        const bf16_t* urow = T.PROJ + (t0 + t) * PP + COL_U + 64 * g + 4 * hi; bf16_t* orow = T.MIX + (t0 + t) * MP + 64 * g + 4 * hi;
#pragma unroll
        for (int rq = 0; rq < 4; ++rq) { const u32x2 u0 = *(const u32x2*)(urow + 8 * rq), u1 = *(const u32x2*)(urow + 32 + 8 * rq); u32x2 w0, w1;
            w0.x = cvtpk(gelu_tanh(bf2f(u0.x & 0xffff)) * (z0[4 * rq] + bs), gelu_tanh(bf2f(u0.x >> 16)) * (z0[4 * rq + 1] + bs)); w0.y = cvtpk(gelu_tanh(bf2f(u0.y & 0xffff)) * (z0[4 * rq + 2] + bs), gelu_tanh(bf2f(u0.y >> 16)) * (z0[4 * rq + 3] + bs));
            w1.x = cvtpk(gelu_tanh(bf2f(u1.x & 0xffff)) * (z1[4 * rq] + bs), gelu_tanh(bf2f(u1.x >> 16)) * (z1[4 * rq + 1] + bs)); w1.y = cvtpk(gelu_tanh(bf2f(u1.y & 0xffff)) * (z1[4 * rq + 2] + bs), gelu_tanh(bf2f(u1.y >> 16)) * (z1[4 * rq + 3] + bs));
            *(u32x2*)(orow + 8 * rq) = w0; *(u32x2*)(orow + 32 + 8 * rq) = w1; }
    }
    MX_WAIT_L0();
}
}
constexpr int NWAVES = 8;
#ifndef MK_N_LAUNCHES
#define MK_N_LAUNCHES 1
#endif
constexpr int N_PHASES = 9;
constexpr int N_LAUNCHES = MK_N_LAUNCHES;

constexpr int BATCH = 16, T = 2048, D = 1024, NIN = 2816, FF = 2816, NGU = 2 * FF;
constexpr int M = BATCH * T;
constexpr float EPS = 1e-6f;

constexpr size_t MiB = 1u << 20;
constexpr size_t WS_CTL = 0, CTL_ZERO_BYTES = 1 * MiB;
constexpr size_t WS_WIN = 2 * MiB, WS_WOUT = 8 * MiB, WS_WGU = 10 * MiB, WS_WDN = 21 * MiB, WS_WSP = 27 * MiB;
constexpr size_t WS_LSE = 28 * MiB;
constexpr size_t WS_FG = 32 * MiB, WS_FU = 44 * MiB, WS_LG = 56 * MiB;
constexpr size_t WS_XN = 68 * MiB;
constexpr size_t WS_PROJ = 132 * MiB, WS_KV = 212 * MiB;
constexpr size_t WS_ACT = WS_PROJ;
constexpr size_t WS_MIX = 308 * MiB;
constexpr size_t WS_Y = 372 * MiB, WS_END = 500 * MiB;
static_assert(WS_WIN + (size_t)NIN * D * 2 <= WS_WOUT && WS_WOUT + (size_t)D * D * 2 <= WS_WGU && WS_WGU + (size_t)NGU * D * 2 <= WS_WDN && WS_WDN + (size_t)D * FF * 2 <= WS_WSP && WS_WSP + 4 * 128 * 128 * 2 <= WS_LSE, "ws map (weights)");
static_assert(WS_LSE + (size_t)M * 12 * 4 <= WS_FG && WS_FG + (size_t)(M / 64) * 2 * FF * 4 <= WS_FU && WS_LG + (size_t)(M / 64) * 2 * FF * 4 <= WS_XN && WS_XN + (size_t)M * D * 2 <= WS_PROJ && WS_PROJ + (size_t)M * 1280 * 2 <= WS_KV && WS_KV + (size_t)M * 1536 * 2 <= WS_MIX && WS_ACT + (size_t)M * FF * 2 <= WS_MIX && WS_MIX + (size_t)M * D * 2 <= WS_Y && WS_Y + (size_t)M * D * 4 <= WS_END, "ws map");
constexpr int CW_TMO = 0, CW_CODE = 1;
constexpr int CW_BAR = 4096;

constexpr int RING_OFF = 0, RING_BYTES = 131072;
constexpr int LUT_OFF = RING_BYTES, LUT_BYTES = 3 * 256 * 4;
constexpr int LDSCTL_OFF = LUT_OFF + LUT_BYTES, MISC_OFF = LDSCTL_OFF + 320;
constexpr int LDS_BYTES = 147456;
static_assert(MISC_OFF + 128 <= LDS_BYTES, "LDS map");

#define GAS __attribute__((address_space(1)))
#define LAS __attribute__((address_space(3)))
typedef unsigned short bf16;
typedef unsigned v4u __attribute__((ext_vector_type(4)));
typedef float f32x4 __attribute__((ext_vector_type(4)));
typedef short bf16x8 __attribute__((ext_vector_type(8)));
typedef GAS unsigned gu32;
typedef GAS unsigned long long gu64;
#define RLX_AGENT __ATOMIC_RELAXED, __HIP_MEMORY_SCOPE_AGENT
#define LDS_WAIT() asm volatile("s_waitcnt lgkmcnt(0)" ::: "memory")
#define VM_WAIT() asm volatile("s_waitcnt vmcnt(0)" ::: "memory")
__device__ __forceinline__ unsigned long long rt() { return __builtin_amdgcn_s_memrealtime(); }
__device__ __forceinline__ unsigned f2bf(float f) { unsigned u = __builtin_bit_cast(unsigned, f); return (u + 0x7fffu + ((u >> 16) & 1u)) >> 16; }
__device__ __forceinline__ unsigned pk2(float lo, float hi) { return f2bf(lo) | (f2bf(hi) << 16); }

#define XB_TMO      128
#define XB_XCNT(j)  (256  + 64 * (j))
#define XB_XSUB(j)  (1280 + 64 * (j))
#define XB_XGEN(j)  (2304 + 64 * (j))
#define XB_TOP      3328
#define XB_TOPGEN   3392
#define XCD_BAR_WORDS 3456
#define XB_SPIN_CAP (1u << 18)

__device__ __forceinline__ unsigned xb_ld(unsigned* p)              { return __hip_atomic_load(p, __ATOMIC_RELAXED, __HIP_MEMORY_SCOPE_AGENT); }
__device__ __forceinline__ unsigned xb_add(unsigned* p, unsigned v) { return __hip_atomic_fetch_add(p, v, __ATOMIC_RELAXED, __HIP_MEMORY_SCOPE_AGENT); }
__device__ __forceinline__ unsigned xb_xcc_id() { return (unsigned)__builtin_amdgcn_s_getreg((3 << 11) | 20) & 0xFu; }
#define XB_SPIN(cond, bar) do { unsigned _sp = 0; while (cond) { __builtin_amdgcn_s_sleep(1); \
    if ((++_sp & 255u) == 0u) { if (xb_ld(&(bar)[XB_TMO])) break; if (_sp > XB_SPIN_CAP) { atomicAdd(&(bar)[XB_TMO], 1u); break; } } } } while (0)

struct XcdBarrier {
    unsigned* bar; unsigned x;
    volatile LAS unsigned* st;
};

__device__ __forceinline__ XcdBarrier xcd_barrier_post(unsigned* bar, volatile LAS unsigned* st) {
    XcdBarrier b; b.bar = bar; b.x = xb_xcc_id(); b.st = st;
    if (threadIdx.x == 0) (void)xb_add(&bar[XB_XCNT(b.x)], 1u);
    return b;
}
__device__ __forceinline__ void xcd_barrier_complete(unsigned* bar, unsigned x, unsigned& nloc, unsigned& nx) {
    const unsigned G = gridDim.x * gridDim.y * gridDim.z;
    unsigned sum, cnt, mine, sp = 0u;
    for (;;) {
        sum = 0u; cnt = 0u; mine = 0u;
#pragma unroll
        for (unsigned j = 0; j < 16; ++j) { const unsigned c = xb_ld(&bar[XB_XCNT(j)]); sum += c; cnt += (c > 0u) ? 1u : 0u; mine = (j == x) ? c : mine; }
        if (sum == G) break;
        __builtin_amdgcn_s_sleep(1);
        if ((++sp & 255u) == 0u) { if (xb_ld(&bar[XB_TMO])) break; if (sp > XB_SPIN_CAP) { atomicAdd(&bar[XB_TMO], 1u); break; } }
    }
    nloc = mine > 0u ? mine : 1u; nx = cnt > 0u ? cnt : 1u;
}

__device__ __forceinline__ void xcd_barrier(const XcdBarrier& b) {
    asm volatile("s_waitcnt vmcnt(0)" ::: "memory");
    __syncthreads();
    if (threadIdx.x == 0) {
        unsigned* bar = b.bar;
        __builtin_amdgcn_s_waitcnt(0);
        unsigned nloc = b.st[0], nx = b.st[1];
        if (nloc == 0u) { xcd_barrier_complete(bar, b.x, nloc, nx); b.st[0] = nloc; b.st[1] = nx; }
        const unsigned old = xb_add(&bar[XB_XSUB(b.x)], 1u);
        const unsigned gen = old / nloc;
        if (old + 1u == (gen + 1u) * nloc) {
            __builtin_amdgcn_fence(__ATOMIC_RELEASE, "agent");
            asm volatile("s_waitcnt vmcnt(0)" ::: "memory");
            const unsigned og = xb_add(&bar[XB_TOP], 1u);
            const unsigned tg = og / nx;
            if (og + 1u == (tg + 1u) * nx) xb_add(&bar[XB_TOPGEN], 1u);
            else XB_SPIN(xb_ld(&bar[XB_TOPGEN]) == tg, bar);
            __builtin_amdgcn_fence(__ATOMIC_ACQUIRE, "agent");
            xb_add(&bar[XB_XGEN(b.x)], 1u);
            asm volatile("s_waitcnt vmcnt(0)" ::: "memory");
        } else {
            XB_SPIN(xb_ld(&bar[XB_XGEN(b.x)]) == gen, bar);
            __builtin_amdgcn_fence(__ATOMIC_ACQUIRE, "agent");
            asm volatile("s_waitcnt vmcnt(0)" ::: "memory");
        }
    }
    __syncthreads();
}


struct Frame {
    LAS unsigned char* lds;
    volatile LAS unsigned* MISC;
    gu32* ctl;
    int tid, lane, wave;
    int vcu, G;
};

__device__ __forceinline__ float wave_sum(float v) {
#pragma unroll
    for (int o = 1; o < 64; o <<= 1) v += __shfl_xor(v, o);
    return v;
}
__device__ __forceinline__ void p0_transpose_item(const float* W, int K, int N, bf16* WT, int k0, int n0, int drow0, LAS float* scr, int lane) {
#pragma unroll 8
    for (int i = 0; i < 32; ++i) { const int kk = 2 * i + (lane >> 5); scr[kk * 33 + (lane & 31)] = W[(size_t)(k0 + kk) * N + n0 + (lane & 31)]; }
    LDS_WAIT(); asm volatile("" ::: "memory");
    const int c = lane & 7;
#pragma unroll
    for (int j = 0; j < 4; ++j) { const int n = (lane >> 3) + 8 * j; const LAS float* s = scr + (8 * c) * 33 + n;
        v4u o; o.x = pk2(s[0 * 33], s[1 * 33]); o.y = pk2(s[2 * 33], s[3 * 33]); o.z = pk2(s[4 * 33], s[5 * 33]); o.w = pk2(s[6 * 33], s[7 * 33]);
        *(GAS v4u*)(WT + (size_t)(drow0 + n) * K + k0 + 8 * c) = o; }
    LDS_WAIT(); asm volatile("" ::: "memory");
}
__device__ __forceinline__ void rms_row_to_bf16(int lane, const float* xrow, const float* g, bf16* orow) {
    const GAS f32x4* xr = (const GAS f32x4*)xrow + lane; const GAS f32x4* gr = (const GAS f32x4*)g + lane;
    f32x4 v[4]; float s = 0.f;
#pragma unroll
    for (int j = 0; j < 4; ++j) { v[j] = xr[64 * j]; s += (v[j].x * v[j].x + v[j].y * v[j].y) + (v[j].z * v[j].z + v[j].w * v[j].w); }
    const float r = 1.f / sqrtf(wave_sum(s) * (1.f / D) + EPS);
    GAS unsigned long long* o8 = (GAS unsigned long long*)orow + lane;
#pragma unroll
    for (int j = 0; j < 4; ++j) { const f32x4 gg = gr[64 * j]; o8[64 * j] = (unsigned long long)pk2(v[j].x * r * gg.x, v[j].y * r * gg.y) | ((unsigned long long)pk2(v[j].z * r * gg.z, v[j].w * r * gg.w) << 32); }
}

struct Args { const float* in[17]; float* out; unsigned char* ws; int ph_lo, ph_hi, li, pad; };

__global__ void __launch_bounds__(NWAVES * 64, 2) mk_fwd(Args args) {
    extern __shared__ __attribute__((aligned(16))) unsigned char lds[];
    Frame F;
    F.lds = (LAS unsigned char*)lds;
    F.MISC = (volatile LAS unsigned*)(F.lds + MISC_OFF);
    F.tid = threadIdx.x; F.lane = F.tid & 63; F.wave = __builtin_amdgcn_readfirstlane(F.tid >> 6);
    F.G = gridDim.x; { const int bx = blockIdx.x; F.vcu = (F.G % 8 == 0) ? (bx % 8) * (F.G / 8) + bx / 8 : bx; }
    unsigned char* ws = args.ws;
    F.ctl = (gu32*)(ws + WS_CTL);
    const float* x = args.in[0]; const float* g_mix_pre = args.in[1]; const float* g_mix_post = args.in[2]; const float* g_ffn_pre = args.in[3]; const float* g_ffn_post = args.in[4];
    const float* w_in = args.in[5]; const float* ln_g = args.in[6]; const float* ln_b = args.in[7]; const float* sp_w = args.in[8]; const float* sp_b = args.in[9]; const float* rel_bias = args.in[10];
    const float* w_out = args.in[11]; const float* w_gate = args.in[12]; const float* w_up = args.in[13]; const float* conv_w = args.in[14]; const float* conv_b = args.in[15]; const float* w_down = args.in[16];
    float* out = args.out;
    bf16* Win_t = (bf16*)(ws + WS_WIN); bf16* Wout_t = (bf16*)(ws + WS_WOUT); bf16* Wgu_t = (bf16*)(ws + WS_WGU); bf16* Wdn_t = (bf16*)(ws + WS_WDN); bf16* Wsp = (bf16*)(ws + WS_WSP);
    bf16* XN = (bf16*)(ws + WS_XN); bf16* PROJ = (bf16*)(ws + WS_PROJ); bf16* KV = (bf16*)(ws + WS_KV); bf16* ACT = (bf16*)(ws + WS_ACT); bf16* MIX = (bf16*)(ws + WS_MIX);
    float* Y = (float*)(ws + WS_Y); float* LSE = (float*)(ws + WS_LSE); float* FG = (float*)(ws + WS_FG); float* FU = (float*)(ws + WS_FU); float* LG = (float*)(ws + WS_LG);

    for (int u = F.tid; u < (LDS_BYTES - LDSCTL_OFF) / 4; u += NWAVES * 64) ((LAS unsigned*)(F.lds + LDSCTL_OFF))[u] = 0u;
    __syncthreads();
    XcdBarrier bar; bar.bar = (unsigned*)(F.ctl + CW_BAR); bar.x = 0; bar.st = nullptr;
    if (N_LAUNCHES == 1) bar = xcd_barrier_post((unsigned*)(F.ctl + CW_BAR), F.MISC + 8);
#define GRID_BAR() do { if (N_LAUNCHES == 1) xcd_barrier(bar); } while (0)
    const int lo = args.ph_lo, hi = args.ph_hi;
#ifndef PHASE_MASK
#define PHASE_MASK 0x1ff
#endif
#define IN(k) (((PHASE_MASK >> (k)) & 1) && lo <= (k) && (k) < hi)
#ifndef REPEAT_MASK
#define REPEAT_MASK 0
#endif
#define PH_BEGIN(k) if (IN(k)) { for (int rep_ = 0; rep_ <= ((REPEAT_MASK >> (k)) & 1); ++rep_) {
#define PH_END(k) if (rep_ < ((REPEAT_MASK >> (k)) & 1)) GRID_BAR(); } if (IN((k) + 1)) GRID_BAR(); }
    const int gw = F.vcu * NWAVES + F.wave, NGW = F.G * NWAVES;

    PH_BEGIN(0)
        LAS float* scr = (LAS float*)(F.lds + RING_OFF + F.wave * 16384);
        constexpr int NB_IN = NIN / 32, NB_D = D / 32, NB_FF = FF / 32;
        constexpr int I_IN = (D / 64) * NB_IN, I_OUT = (D / 64) * NB_D, I_G = (D / 64) * NB_FF, I_DN = (FF / 64) * NB_D;
        constexpr int NITEMS = I_IN + I_OUT + 2 * I_G + I_DN;
        for (int it = gw; it < NITEMS; it += NGW) {
            int r = it;
            if (r < I_IN) { const int kb = r / NB_IN, nb = r % NB_IN; p0_transpose_item(w_in, D, NIN, Win_t, 64 * kb, 32 * nb, 32 * nb, scr, F.lane); continue; } r -= I_IN;
            if (r < I_OUT) { const int kb = r / NB_D, nb = r % NB_D; p0_transpose_item(w_out, D, D, Wout_t, 64 * kb, 32 * nb, 32 * nb, scr, F.lane); continue; } r -= I_OUT;
            if (r < I_G) { const int kb = r / NB_FF, nb = r % NB_FF, n0 = 32 * nb; p0_transpose_item(w_gate, D, FF, Wgu_t, 64 * kb, n0, 256 * (n0 >> 7) + (n0 & 127), scr, F.lane); continue; } r -= I_G;
            if (r < I_G) { const int kb = r / NB_FF, nb = r % NB_FF, n0 = 32 * nb; p0_transpose_item(w_up, D, FF, Wgu_t, 64 * kb, n0, 256 * (n0 >> 7) + 128 + (n0 & 127), scr, F.lane); continue; } r -= I_G;
            { const int kb = r / NB_D, nb = r % NB_D; p0_transpose_item(w_down, FF, D, Wdn_t, 64 * kb, 32 * nb, 32 * nb, scr, F.lane); }
        }
        for (int i = blockIdx.x * 512 + F.tid; i < 4 * 128 * 128; i += F.G * 512) { const int t = (i >> 7) & 127, s = i & 127; Wsp[i] = (bf16)f2bf(s <= t ? sp_w[i] : 0.f); }
        for (int m = gw; m < M; m += NGW) rms_row_to_bf16(F.lane, x + (size_t)m * D, g_mix_pre, XN + (size_t)m * D);
    PH_END(0)
    PH_BEGIN(1)
        pg8::Gemm g{XN, Win_t, M, NIN, D}; pg8::StaticOrder S; S.init(M, NIN, F.G, (int)blockIdx.x);
        pg8::EpiProj E{PROJ, 1280, mixer::C2, KV};
        pg8::gemm_phase<pg8::EpiProj, pg8::StaticOrder, PG8_ALIGN, PG8_SP2>(F.lds + RING_OFF, g, S, E);
    PH_END(1)
    PH_BEGIN(2)
        mixer::Tensors MT{PROJ, KV, MIX, LSE, rel_bias, Wsp, ln_g, ln_b, sp_b};
#ifndef NO_GMLP
        if (args.pad != 2)
        for (int i = F.wave * F.G + F.vcu; i < BATCH * 16 * 4; i += NGW) mixer::gmlp_unit(MT, i >> 6, (i >> 2) & 15, i & 3, (LAS char*)(F.lds + RING_OFF) + F.wave * mixer::SLOT, F.lane);
#endif
#ifndef NO_ATTN
        const int NU = BATCH * 12 * 4, per = (NU + F.G - 1) / F.G;
        for (int i = 0; i < per && args.pad != 1; ++i) { const int U = (F.G == 256) ? (((((F.vcu >> 5) * per + i) * 8 + ((F.vcu & 31) >> 2)) << 2) | ((F.vcu + i) & 3)) : F.vcu * per + i; if (U >= NU) break;
            mixer::attn_unit(MT, (U >> 2) / 12, (U >> 2) % 12, U & 3, (LAS char*)(F.lds + RING_OFF), (LAS float*)(F.lds + LUT_OFF), F.wave, F.lane); }
#endif
        asm volatile("s_waitcnt vmcnt(0) lgkmcnt(0)" ::: "memory"); __syncthreads();
    PH_END(2)
    PH_BEGIN(3)
        pg8::Gemm g{MIX, Wout_t, M, D, D}; pg8::StaticOrder S; S.init(M, D, F.G, (int)blockIdx.x);
        pg8::EpiF32 E{Y, D};
        pg8::gemm_phase<pg8::EpiF32, pg8::StaticOrder, PG8_ALIGN, PG8_SP2>(F.lds + RING_OFF, g, S, E);
    PH_END(3)
    PH_BEGIN(4)
        for (int m = gw; m < M; m += NGW) {
            const GAS f32x4* yr = (const GAS f32x4*)(Y + (size_t)m * D) + F.lane; const GAS f32x4* xr = (const GAS f32x4*)(x + (size_t)m * D) + F.lane;
            const GAS f32x4* g2 = (const GAS f32x4*)g_mix_post + F.lane; const GAS f32x4* g3 = (const GAS f32x4*)g_ffn_pre + F.lane;
            f32x4 v[4]; float s = 0.f;
#pragma unroll
            for (int j = 0; j < 4; ++j) { v[j] = yr[64 * j]; s += (v[j].x * v[j].x + v[j].y * v[j].y) + (v[j].z * v[j].z + v[j].w * v[j].w); }
            const float r = 1.f / sqrtf(wave_sum(s) * (1.f / D) + EPS); float s2 = 0.f;
#pragma unroll
            for (int j = 0; j < 4; ++j) { v[j] = xr[64 * j] + v[j] * r * g2[64 * j]; s2 += (v[j].x * v[j].x + v[j].y * v[j].y) + (v[j].z * v[j].z + v[j].w * v[j].w); }
            const float r2 = 1.f / sqrtf(wave_sum(s2) * (1.f / D) + EPS);
            GAS f32x4* orow = (GAS f32x4*)(out + (size_t)m * D) + F.lane; GAS unsigned long long* o8 = (GAS unsigned long long*)(XN + (size_t)m * D) + F.lane;
#pragma unroll
            for (int j = 0; j < 4; ++j) { orow[64 * j] = v[j]; const f32x4 gg = g3[64 * j];
                o8[64 * j] = (unsigned long long)pk2(v[j].x * r2 * gg.x, v[j].y * r2 * gg.y) | ((unsigned long long)pk2(v[j].z * r2 * gg.z, v[j].w * r2 * gg.w) << 32); }
        }
    PH_END(4)
    PH_BEGIN(5)
        pg8::Gemm g{XN, Wgu_t, M, NGU, D}; pg8::StaticOrder S; S.init(M, NGU, F.G, (int)blockIdx.x);
        pg8::EpiGateUp E{ACT, FF, conv_w, conv_b, FG, FU, LG};
        pg8::gemm_phase<pg8::EpiGateUp, pg8::StaticOrder, PG8_ALIGN, PG8_SP2>(F.lds + RING_OFF, g, S, E);
    PH_END(5)
    PH_BEGIN(6)
        constexpr int NG = M / 64, C4 = FF / 4;
        for (int i = blockIdx.x * 512 + F.tid; i < NG * C4; i += F.G * 512) {
            const int grp = i / C4, c = (i % C4) * 4; if ((grp & 31) == 0) continue;
            const f32x4 g0 = *(const f32x4*)(FG + (size_t)(grp * 2) * FF + c), g1 = *(const f32x4*)(FG + (size_t)(grp * 2 + 1) * FF + c);
            const f32x4 u0 = *(const f32x4*)(FU + (size_t)(grp * 2) * FF + c), u1 = *(const f32x4*)(FU + (size_t)(grp * 2 + 1) * FF + c);
            const f32x4 hm2 = *(const f32x4*)(LG + (size_t)(grp * 2 - 2) * FF + c), hm1 = *(const f32x4*)(LG + (size_t)(grp * 2 - 1) * FF + c);
            const f32x4 w0 = *(const f32x4*)(conv_w + c), w1 = *(const f32x4*)(conv_w + FF + c), w2 = *(const f32x4*)(conv_w + 2 * FF + c), bb = *(const f32x4*)(conv_b + c);
            float a0[4], a1[4];
#pragma unroll
            for (int j = 0; j < 4; ++j) { a0[j] = pg8::gelu_tanh(bb[j] + w2[j] * g0[j] + w1[j] * hm1[j] + w0[j] * hm2[j]) * u0[j]; a1[j] = pg8::gelu_tanh(bb[j] + w2[j] * g1[j] + w1[j] * g0[j] + w0[j] * hm1[j]) * u1[j]; }
            *(unsigned long long*)(ACT + (size_t)(grp * 64) * FF + c) = (unsigned long long)pk2(a0[0], a0[1]) | ((unsigned long long)pk2(a0[2], a0[3]) << 32);
            *(unsigned long long*)(ACT + (size_t)(grp * 64 + 1) * FF + c) = (unsigned long long)pk2(a1[0], a1[1]) | ((unsigned long long)pk2(a1[2], a1[3]) << 32);
        }
    PH_END(6)
    PH_BEGIN(7)
        pg8::Gemm g{ACT, Wdn_t, M, D, FF}; pg8::StaticOrder S; S.init(M, D, F.G, (int)blockIdx.x);
        pg8::EpiF32 E{Y, D};
        pg8::gemm_phase<pg8::EpiF32, pg8::StaticOrder, PG8_ALIGN, PG8_SP2>(F.lds + RING_OFF, g, S, E);
    PH_END(7)
    PH_BEGIN(8)
        for (int m = gw; m < M; m += NGW) {
            const GAS f32x4* yr = (const GAS f32x4*)(Y + (size_t)m * D) + F.lane; GAS f32x4* orow = (GAS f32x4*)(out + (size_t)m * D) + F.lane;
            const GAS f32x4* g4 = (const GAS f32x4*)g_ffn_post + F.lane;
            f32x4 v[4]; float s = 0.f;
#pragma unroll
            for (int j = 0; j < 4; ++j) { v[j] = yr[64 * j]; s += (v[j].x * v[j].x + v[j].y * v[j].y) + (v[j].z * v[j].z + v[j].w * v[j].w); }
            const float r = 1.f / sqrtf(wave_sum(s) * (1.f / D) + EPS);
#pragma unroll
            for (int j = 0; j < 4; ++j) orow[64 * j] = orow[64 * j] + v[j] * r * g4[64 * j];
        }
    } }
#undef IN
#undef GRID_BAR
}

extern "C" void kernel_launch(void* const* d_in, const int* in_sizes, int n_in, void* d_out, int out_size, void* d_ws, size_t ws_size, hipStream_t stream) {
    static int grid = 0;
    if (grid == 0) {
        if (n_in != 17 || in_sizes[0] != M * D || out_size != M * D || ws_size < WS_END) { fprintf(stderr, "kernel_launch: unexpected shapes: n_in %d in0 %d out %d ws %zu (need %zu)\n", n_in, n_in > 0 ? in_sizes[0] : -1, out_size, ws_size, (size_t)WS_END); grid = -1; return; }
        int dev = 0, cus = 0, per_cu = 0;
        if (hipGetDevice(&dev) != hipSuccess || hipDeviceGetAttribute(&cus, hipDeviceAttributeMultiprocessorCount, dev) != hipSuccess) { grid = -1; return; }
        if (hipFuncSetAttribute((const void*)mk_fwd, hipFuncAttributeMaxDynamicSharedMemorySize, LDS_BYTES) != hipSuccess) { fprintf(stderr, "kernel_launch: hipFuncSetAttribute failed\n"); grid = -1; return; }
        if (hipOccupancyMaxActiveBlocksPerMultiprocessor(&per_cu, (const void*)mk_fwd, NWAVES * 64, LDS_BYTES) != hipSuccess || per_cu < 1) fprintf(stderr, "kernel_launch: note: occupancy query reports %d workgroups per CU\n", per_cu);
        (void)hipGetLastError();
        grid = cus;
    }
    if (grid < 0) return;
    if (hipMemsetAsync((char*)d_ws + WS_CTL, 0, CTL_ZERO_BYTES, stream) != hipSuccess) { fprintf(stderr, "kernel_launch: hipMemsetAsync failed\n"); return; }
    Args a{};
    for (int i = 0; i < 17; ++i) a.in[i] = (const float*)d_in[i];
    a.out = (float*)d_out; a.ws = (unsigned char*)d_ws;
    for (int li = 0; li < N_LAUNCHES; ++li) {
        a.ph_lo = (N_LAUNCHES == 1) ? 0 : li; a.ph_hi = (N_LAUNCHES == 1) ? N_PHASES : li + 1; a.li = li;
        hipLaunchKernelGGL(mk_fwd, dim3(grid), dim3(NWAVES * 64), LDS_BYTES, stream, a);
#ifdef HOST_REPEAT_MASK
#ifndef HOST_REPEAT_SUB
#define HOST_REPEAT_SUB 0
#endif
        if (N_LAUNCHES > 1 && ((HOST_REPEAT_MASK >> li) & 1)) { a.pad = HOST_REPEAT_SUB; hipLaunchKernelGGL(mk_fwd, dim3(grid), dim3(NWAVES * 64), LDS_BYTES, stream, a); a.pad = 0; }
#endif
        const hipError_t le = hipPeekAtLastError();
        if (le != hipSuccess) { fprintf(stderr, "kernel_launch: launch %d failed: %s\n", li, hipGetErrorName(le)); break; }
    }
}
```
